# Optimizing an MI355X kernel written in HIP

```python
import jax, jax.numpy as jnp
from jax import lax
import numpy as np

D_MODEL = 1024
BATCH = 32
SEQ = 2048
DEPTH = 4
DEC_BATCH = 32
DEC_SEQ = 32
PAST_LEN = 2048

CHUNK = 64
D_MIX = D_MODEL
N_HEADS_ATTN = 8
HEAD_DIM = 64
D_ATTN = N_HEADS_ATTN * HEAD_DIM
D_CONV = D_MIX - D_ATTN
CONV_WIDTH = 3
D_FF = 2816
FFN_CONV_WIDTH = 3
Q_BLOCK = 128
ALPHA = (2 * DEPTH) ** 0.25
BETA = (8 * DEPTH) ** -0.25
LN_EPS = 1e-5
D_IN = 3 * D_ATTN + N_HEADS_ATTN + 3 * D_CONV
SPLITS = [D_ATTN, 2 * D_ATTN, 3 * D_ATTN, 3 * D_ATTN + N_HEADS_ATTN,
          3 * D_ATTN + N_HEADS_ATTN + D_CONV, 3 * D_ATTN + N_HEADS_ATTN + 2 * D_CONV]

kernel_name = "fox_shortconv_convffn_deepnorm_stream_step"


def _layer_norm(x, g, b):
    xf = x.astype(jnp.float32)
    mu = jnp.mean(xf, axis=-1, keepdims=True)
    var = jnp.mean(jnp.square(xf - mu), axis=-1, keepdims=True)
    y = (xf - mu) * lax.rsqrt(var + LN_EPS) * g.astype(jnp.float32) + b.astype(jnp.float32)
    return y.astype(x.dtype)


def _causal_dwconv(u_ext, w, b, out_len):
    y = b
    for i in range(w.shape[0]):
        y = y + w[i] * u_ext[:, i:i + out_len]
    return y


def _fox_attend(q, k, v, c_q, c_k, q_pos, k_pos):
    s = jnp.einsum('nqhd,nkhd->nhqk', q.astype(jnp.float32), k.astype(jnp.float32)) * (HEAD_DIM ** -0.5)
    s = s + jnp.transpose(c_q, (0, 2, 1))[:, :, :, None] - jnp.transpose(c_k, (0, 2, 1))[:, :, None, :]
    mask = k_pos[None, :] <= q_pos[:, None]
    s = jnp.where(mask[None, None], s, -jnp.inf)
    p = jax.nn.softmax(s, axis=-1)
    return jnp.einsum('nhqk,nkhd->nqhd', p.astype(v.dtype), v)


def _fox_prompt(q, k, v, logf):
    T = q.shape[1]
    c = jnp.cumsum(logf, axis=1)
    pos = jnp.arange(T)
    outs = []
    for blk in range(T // Q_BLOCK):
        lo, hi = blk * Q_BLOCK, (blk + 1) * Q_BLOCK
        outs.append(_fox_attend(q[:, lo:hi], k[:, :hi], v[:, :hi], c[:, lo:hi], c[:, :hi], pos[lo:hi], pos[:hi]))
    return jnp.concatenate(outs, axis=1)


def _fox_sample(q, k, v, logf, cache_k, cache_v, cache_logf):
    P, T = cache_k.shape[1], q.shape[1]
    k_all = jnp.concatenate([cache_k, k], axis=1)
    v_all = jnp.concatenate([cache_v, v], axis=1)
    c = jnp.cumsum(jnp.concatenate([cache_logf.astype(jnp.float32), logf], axis=1), axis=1)
    pos = jnp.arange(P + T)
    return _fox_attend(q, k_all, v_all, c[:, P:], c, pos[P:], pos)


def _layer(x, w_in, b_f, conv_w, conv_b, w_out, ln1_g, ln1_b,
           w_up, ffn_conv_w, ffn_conv_b, w_down, ln2_g, ln2_b, past=None):
    N, T, _ = x.shape
    proj = x @ w_in
    q, k, v, f_logit, gate_b, gate_c, h = jnp.split(proj, SPLITS, axis=-1)
    q = q.reshape(N, T, N_HEADS_ATTN, HEAD_DIM)
    k = k.reshape(N, T, N_HEADS_ATTN, HEAD_DIM)
    v = v.reshape(N, T, N_HEADS_ATTN, HEAD_DIM)
    logf = jax.nn.log_sigmoid((f_logit + b_f).astype(jnp.float32))
    u = gate_c * h
    if past is None:
        attn = _fox_prompt(q, k, v, logf)
        u_ext = jnp.pad(u, ((0, 0), (CONV_WIDTH - 1, 0), (0, 0)))
    else:
        cache_k, cache_v, cache_logf, mix_state, ffn_state = past
        attn = _fox_sample(q, k, v, logf, cache_k, cache_v, cache_logf)
        u_ext = jnp.concatenate([mix_state.astype(u.dtype), u], axis=1)
    conv_out = gate_b * _causal_dwconv(u_ext, conv_w, conv_b, T)
    mixed = jnp.concatenate([attn.reshape(N, T, D_ATTN), conv_out], axis=-1) @ w_out
    x = _layer_norm(ALPHA * x + mixed, ln1_g, ln1_b)

    up = x @ w_up
    g, val = jnp.split(up, [D_FF], axis=-1)
    if past is None:
        g_ext = jnp.pad(g, ((0, 0), (FFN_CONV_WIDTH - 1, 0), (0, 0)))
    else:
        g_ext = jnp.concatenate([ffn_state.astype(g.dtype), g], axis=1)
    a = jax.nn.silu(_causal_dwconv(g_ext, ffn_conv_w, ffn_conv_b, T)) * val
    x = _layer_norm(ALPHA * x + a @ w_down, ln2_g, ln2_b)
    new_state = (k, v, logf, u_ext[:, -(CONV_WIDTH - 1):], g_ext[:, -(FFN_CONV_WIDTH - 1):])
    return x, new_state


def setup_inputs(seed: int = 0) -> dict:
    key = jax.random.key(seed)
    ks = jax.random.split(key, 24)
    f32 = jnp.float32
    nrm = lambda k, shape, s: jax.random.normal(k, shape, f32) * s
    return {
        "x_prompt": nrm(ks[0], (BATCH, SEQ, D_MODEL), 1.0),
        "x_sample": nrm(ks[1], (DEC_BATCH, DEC_SEQ, D_MODEL), 1.0),
        "cache_k": nrm(ks[2], (DEPTH, DEC_BATCH, PAST_LEN, N_HEADS_ATTN, HEAD_DIM), 1.0),
        "cache_v": nrm(ks[3], (DEPTH, DEC_BATCH, PAST_LEN, N_HEADS_ATTN, HEAD_DIM), 1.0),
        "cache_logf": jax.nn.log_sigmoid(jax.random.uniform(ks[4], (DEPTH, DEC_BATCH, PAST_LEN, N_HEADS_ATTN), f32, 1.0, 4.0)
                                          + nrm(ks[5], (DEPTH, DEC_BATCH, PAST_LEN, N_HEADS_ATTN), 1.0)),
        "state_mix_conv": nrm(ks[6], (DEPTH, DEC_BATCH, CONV_WIDTH - 1, D_CONV), 1.0),
        "state_ffn_conv": nrm(ks[7], (DEPTH, DEC_BATCH, FFN_CONV_WIDTH - 1, D_FF), 1.0),
        "w_in": nrm(ks[8], (DEPTH, D_MODEL, D_IN), D_MODEL ** -0.5),
        "b_f": jax.random.uniform(ks[9], (DEPTH, N_HEADS_ATTN), f32, 1.0, 4.0),
        "conv_w": nrm(ks[10], (DEPTH, CONV_WIDTH, D_CONV), CONV_WIDTH ** -0.5),
        "conv_b": nrm(ks[11], (DEPTH, D_CONV), 0.01),
        "w_out": nrm(ks[12], (DEPTH, D_MIX, D_MODEL), BETA * D_MIX ** -0.5),
        "ln1_g": 1.0 + nrm(ks[13], (DEPTH, D_MODEL), 0.01),
        "ln1_b": nrm(ks[14], (DEPTH, D_MODEL), 0.01),
        "w_up": nrm(ks[15], (DEPTH, D_MODEL, 2 * D_FF), D_MODEL ** -0.5),
        "ffn_conv_w": nrm(ks[16], (DEPTH, FFN_CONV_WIDTH, D_FF), FFN_CONV_WIDTH ** -0.5),
        "ffn_conv_b": nrm(ks[17], (DEPTH, D_FF), 0.01),
        "w_down": nrm(ks[18], (DEPTH, D_FF, D_MODEL), BETA * D_FF ** -0.5),
        "ln2_g": 1.0 + nrm(ks[19], (DEPTH, D_MODEL), 0.01),
        "ln2_b": nrm(ks[20], (DEPTH, D_MODEL), 0.01),
    }


def reference(x_prompt, x_sample, cache_k, cache_v, cache_logf, state_mix_conv, state_ffn_conv,
              w_in, b_f, conv_w, conv_b, w_out, ln1_g, ln1_b,
              w_up, ffn_conv_w, ffn_conv_b, w_down, ln2_g, ln2_b):
    yp, ys = x_prompt, x_sample
    sp_list, ss_list = [], []
    for l in range(DEPTH):
        lw = (w_in[l], b_f[l], conv_w[l], conv_b[l], w_out[l], ln1_g[l], ln1_b[l],
              w_up[l], ffn_conv_w[l], ffn_conv_b[l], w_down[l], ln2_g[l], ln2_b[l])
        yp, sp = _layer(yp, *lw)
        ys, ss = _layer(ys, *lw, past=(cache_k[l], cache_v[l], cache_logf[l], state_mix_conv[l], state_ffn_conv[l]))
        sp_list.append(sp)
        ss_list.append(ss)
    k_prompt = jnp.stack([s[0] for s in sp_list])
    v_prompt = jnp.stack([s[1] for s in sp_list])
    logf_prompt = jnp.stack([s[2] for s in sp_list])
    mix_conv_prompt = jnp.stack([s[3] for s in sp_list])
    ffn_conv_prompt = jnp.stack([s[4] for s in sp_list])
    k_sample = jnp.stack([s[0] for s in ss_list])
    v_sample = jnp.stack([s[1] for s in ss_list])
    logf_sample = jnp.stack([s[2] for s in ss_list])
    mix_conv_sample = jnp.stack([s[3] for s in ss_list])
    ffn_conv_sample = jnp.stack([s[4] for s in ss_list])
    return (yp, ys, k_prompt, v_prompt, logf_prompt, mix_conv_prompt, ffn_conv_prompt,
            k_sample, v_sample, logf_sample, mix_conv_sample, ffn_conv_sample)
```

```cpp
#include <hip/hip_runtime.h>
#include <hip/hip_bf16.h>
#include <cstdio>
#include <cstdint>
#include <cmath>
namespace pg8 {
#define PG8_LAS __attribute__((address_space(3)))
typedef unsigned short bf16_t;
typedef short bf16x8 __attribute__((ext_vector_type(8)));
typedef float f32x4 __attribute__((ext_vector_type(4)));
typedef unsigned u32x4 __attribute__((ext_vector_type(4)));
constexpr int BM = 256, BK = 64, HALF = 128, HTB = HALF * BK * 2  , STAGE_BYTES = 8 * HTB, NXCD = 8, WGM = 8;

__host__ __device__ __forceinline__ int lds_byte(int r, int c) { const int st = (r >> 4) * 2 + (c >> 5), rr = r & 15, cc = c & 31, ob = rr * 64 + cc * 2; return st * 1024 + (ob ^ (((ob >> 9) & 1) << 5)); }
__host__ __device__ __forceinline__ void stage_rc(int b, int& R, int& C) { const int st = b / 1024, sb = b % 1024, swz = sb ^ (((sb >> 9) & 1) << 5); R = (st >> 1) * 16 + swz / 64; C = (st & 1) * 32 + (swz % 64) / 2; }
__host__ __device__ __forceinline__ int perm32(int rho) { const int n = rho >> 4, i = rho & 15; return 8 * (i >> 2) + 4 * n + (i & 3); }

struct Unit { int pm, pn; };
struct Gemm { const bf16_t* A; const bf16_t* Bt; int M, N, K; };

struct StaticOrder {
    int nM, nN, nwg, G, c;
    __host__ __device__ void init(int M, int N, int G_, int c_) { nM = M / BM; nN = N / BM; nwg = nM * nN; G = G_; c = c_; }
    __host__ __device__ bool next(int i, Unit& u) const {
        const long L = (long)i * G + c; if (L >= nwg) return false;
        int wgid = (int)L; { const int q = nwg / NXCD, r = nwg % NXCD, xcd = wgid % NXCD, off = wgid / NXCD; wgid = (xcd < r ? xcd * (q + 1) : r * (q + 1) + (xcd - r) * q) + off; }
        const int nig = WGM * nN, gid = wgid / nig, fm = gid * WGM, gsz = (nM - fm) < WGM ? (nM - fm) : WGM;
        u.pm = fm + ((wgid % nig) % gsz); u.pn = (wgid % nig) / gsz; return true;
    }
    __device__ __forceinline__ void a_ready(const Unit&) const {}
    __device__ __forceinline__ void done(const Unit&) const {}
};

__device__ __forceinline__ unsigned cvt_pk_bf16(float lo, float hi) { unsigned r; asm volatile("v_cvt_pk_bf16_f32 %0, %1, %2" : "=v"(r) : "v"(lo), "v"(hi)); return r; }
typedef float f32x2 __attribute__((ext_vector_type(2)));
typedef unsigned u32x2 __attribute__((ext_vector_type(2)));
__device__ __forceinline__ u32x4 pack8_bf16(const f32x4 v0, const f32x4 v1) { u32x4 w; w.x = cvt_pk_bf16(v0[0], v0[1]); w.y = cvt_pk_bf16(v0[2], v0[3]); w.z = cvt_pk_bf16(v1[0], v1[1]); w.w = cvt_pk_bf16(v1[2], v1[3]); return w; }
__device__ __forceinline__ float log_sigmoid_f(float z) { return fminf(z, 0.f) - log1pf(__expf(-fabsf(z))); }
constexpr int EP_MP = 65536, EP_MS = 1024, EP_MT = EP_MP + EP_MS;
constexpr size_t EP_OUT_KP = (size_t)EP_MT * 1024, EP_OUT_VP = EP_OUT_KP + 4ull * EP_MP * 512, EP_OUT_LFP = EP_OUT_VP + 4ull * EP_MP * 512, EP_OUT_MCP = EP_OUT_LFP + 4ull * EP_MP * 8,
    EP_OUT_FCP = EP_OUT_MCP + 4ull * 32 * 2 * 512, EP_OUT_KS = EP_OUT_FCP + 4ull * 32 * 2 * 2816, EP_OUT_VS = EP_OUT_KS + 4ull * EP_MS * 512, EP_OUT_LFS = EP_OUT_VS + 4ull * EP_MS * 512,
    EP_OUT_MCS = EP_OUT_LFS + 4ull * EP_MS * 8, EP_OUT_FCS = EP_OUT_MCS + 4ull * 32 * 2 * 512;
constexpr size_t EP_WS_R = 852ull << 20, EP_A512 = (size_t)EP_MT * 512 * 2, EP_WS_Q = EP_WS_R, EP_WS_K = EP_WS_Q + EP_A512, EP_WS_V = EP_WS_K + EP_A512, EP_WS_BG = EP_WS_V + EP_A512, EP_WS_U = EP_WS_BG + EP_A512,
    EP_WS_G = EP_WS_R, EP_WS_VAL = EP_WS_G + (size_t)EP_MT * 2816 * 2;
struct EpiInProj {
    static constexpr bool PERM = true, AFTER_DRAIN = false;
    unsigned char* ws; float* out; const float* bfl; int l; float qscale;
    __device__ __forceinline__ void operator()(const f32x4 (&acc)[2][2][4][2], const Unit& u, int wr, int wc, int fr, int fq) const {
        bf16_t *Q = (bf16_t*)(ws + EP_WS_Q), *Kb = (bf16_t*)(ws + EP_WS_K), *Vb = (bf16_t*)(ws + EP_WS_V), *Bg = (bf16_t*)(ws + EP_WS_BG), *U = (bf16_t*)(ws + EP_WS_U);
        float *kout_p = out + EP_OUT_KP + (size_t)l * EP_MP * 512, *vout_p = out + EP_OUT_VP + (size_t)l * EP_MP * 512, *kout_s = out + EP_OUT_KS + (size_t)l * EP_MS * 512, *vout_s = out + EP_OUT_VS + (size_t)l * EP_MS * 512;
        float *lf_p = out + EP_OUT_LFP + (size_t)l * EP_MP * 8, *lf_s = out + EP_OUT_LFS + (size_t)l * EP_MS * 8, *mc_p = out + EP_OUT_MCP + (size_t)l * 32 * 2 * 512, *mc_s = out + EP_OUT_MCS + (size_t)l * 32 * 2 * 512;
        const int pn = u.pn, row0 = u.pm * BM + wr * 64 + fr, c8 = wc * 32 + 8 * fq;
        const bool samp = u.pm >= (EP_MP / BM);
        if (pn < 8 && (pn < 2 || pn >= 6)) {
            bf16_t* base = (pn < 2 ? Q + pn * BM : Bg + (pn - 6) * BM) + (size_t)row0 * 512 + c8; const float sc = pn < 2 ? qscale : 1.f;
#pragma unroll
            for (int ai = 0; ai < 2; ++ai)
#pragma unroll
                for (int m = 0; m < 4; ++m) { bf16_t* rowp = base + (size_t)(ai * HALF + m * 16) * 512;
#pragma unroll
                    for (int bj = 0; bj < 2; ++bj) *(u32x4*)(rowp + bj * HALF) = pack8_bf16(acc[ai][bj][m][0] * sc, acc[ai][bj][m][1] * sc); }
        } else if (pn < 6) {
            const int isv = pn >= 4, ct = (pn - (isv ? 4 : 2)) * BM + c8;
            bf16_t* base = (isv ? Vb : Kb) + (size_t)row0 * 512 + ct;
            float* fb = samp ? (isv ? vout_s : kout_s) + (size_t)(row0 - EP_MP) * 512 + ct : (isv ? vout_p : kout_p) + (size_t)row0 * 512 + ct;
#pragma unroll
            for (int ai = 0; ai < 2; ++ai)
#pragma unroll
                for (int m = 0; m < 4; ++m) { const size_t ro = (size_t)(ai * HALF + m * 16) * 512;
#pragma unroll
                    for (int bj = 0; bj < 2; ++bj) { *(u32x4*)(base + ro + bj * HALF) = pack8_bf16(acc[ai][bj][m][0], acc[ai][bj][m][1]);
                        *(f32x4*)(fb + ro + bj * HALF) = acc[ai][bj][m][0]; *(f32x4*)(fb + ro + bj * HALF + 4) = acc[ai][bj][m][1]; } }
        } else if (pn < 12) {
            const int ct = (pn - 8) * HALF + c8;
            bf16_t* base = U + (size_t)row0 * 512 + ct;
#pragma unroll
            for (int ai = 0; ai < 2; ++ai)
#pragma unroll
                for (int m = 0; m < 4; ++m) { const int row = row0 + ai * HALF + m * 16;
                    const f32x4 u0 = acc[ai][0][m][0] * acc[ai][1][m][0], u1 = acc[ai][0][m][1] * acc[ai][1][m][1];
                    *(u32x4*)(base + (size_t)(ai * HALF + m * 16) * 512) = pack8_bf16(u0, u1);
                    float* d = nullptr;
                    if (!samp) { const int t = row & 2047; if (t >= 2046) d = mc_p + ((size_t)(row >> 11) * 2 + (t - 2046)) * 512 + ct; }
                    else { const int rs = row - EP_MP, t = rs & 31; if (t >= 30) d = mc_s + ((size_t)(rs >> 5) * 2 + (t - 30)) * 512 + ct; }
                    if (d) { *(f32x4*)d = u0; *(f32x4*)(d + 4) = u1; } }
        } else {
            if (wc == 0 && fq == 0) {
                const f32x4 b0 = *(const f32x4*)bfl, b1 = *(const f32x4*)(bfl + 4);
                float* fb = samp ? lf_s + (size_t)(row0 - EP_MP) * 8 : lf_p + (size_t)row0 * 8;
#pragma unroll
                for (int ai = 0; ai < 2; ++ai)
#pragma unroll
                    for (int m = 0; m < 4; ++m) { const f32x4 z0 = acc[ai][0][m][0] + b0, z1 = acc[ai][0][m][1] + b1; f32x4 r0, r1;
#pragma unroll
                        for (int i = 0; i < 4; ++i) { r0[i] = log_sigmoid_f(z0[i]); r1[i] = log_sigmoid_f(z1[i]); }
                        float* d = fb + (size_t)(ai * HALF + m * 16) * 8; *(f32x4*)d = r0; *(f32x4*)(d + 4) = r1; }
            }
        }
    }
};
struct EpiF32 {
    static constexpr bool PERM = false, AFTER_DRAIN = false;
    float* Y; int ldc;
    __device__ __forceinline__ void operator()(const f32x4 (&acc)[2][2][4][2], const Unit& u, int wr, int wc, int fr, int fq) const {
        float* base = Y + (size_t)(u.pm * BM + wr * 64 + fr) * ldc + u.pn * BM + wc * 32 + 4 * fq;
#pragma unroll
        for (int ai = 0; ai < 2; ++ai)
#pragma unroll
            for (int m = 0; m < 4; ++m) { float* rowp = base + (size_t)(ai * HALF + m * 16) * ldc;
#pragma unroll
                for (int bj = 0; bj < 2; ++bj)
#pragma unroll
                    for (int n = 0; n < 2; ++n) *(f32x4*)(rowp + bj * HALF + n * 16) = acc[ai][bj][m][n]; }
    }
};
struct EpiUp {
    static constexpr bool PERM = true, AFTER_DRAIN = false;
    unsigned char* ws; float* out; int l;
    __device__ __forceinline__ void operator()(const f32x4 (&acc)[2][2][4][2], const Unit& u, int wr, int wc, int fr, int fq) const {
        bf16_t *G = (bf16_t*)(ws + EP_WS_G), *VAL = (bf16_t*)(ws + EP_WS_VAL); float *fc_p = out + EP_OUT_FCP + (size_t)l * 32 * 2 * 2816, *fc_s = out + EP_OUT_FCS + (size_t)l * 32 * 2 * 2816;
        const int pn = u.pn, row0 = u.pm * BM + wr * 64 + fr, c8 = wc * 32 + 8 * fq;
        const bool samp = u.pm >= (EP_MP / BM), isg = pn < 11;
        const int ct = (isg ? pn : pn - 11) * BM + c8;
        bf16_t* base = (isg ? G : VAL) + (size_t)row0 * 2816 + ct;
#pragma unroll
        for (int ai = 0; ai < 2; ++ai)
#pragma unroll
            for (int m = 0; m < 4; ++m) { const int row = row0 + ai * HALF + m * 16;
#pragma unroll
                for (int bj = 0; bj < 2; ++bj) *(u32x4*)(base + (size_t)(ai * HALF + m * 16) * 2816 + bj * HALF) = pack8_bf16(acc[ai][bj][m][0], acc[ai][bj][m][1]);
                if (isg) { float* d = nullptr;
                    if (!samp) { const int t = row & 2047; if (t >= 2046) d = fc_p + ((size_t)(row >> 11) * 2 + (t - 2046)) * 2816 + ct; }
                    else { const int rs = row - EP_MP, t = rs & 31; if (t >= 30) d = fc_s + ((size_t)(rs >> 5) * 2 + (t - 30)) * 2816 + ct; }
                    if (d) {
#pragma unroll
                        for (int bj = 0; bj < 2; ++bj) { *(f32x4*)(d + bj * HALF) = acc[ai][bj][m][0]; *(f32x4*)(d + bj * HALF + 4) = acc[ai][bj][m][1]; } } } }
    }
};
template <class Epi, class Sched, bool ALIGN_EPI = false, bool SP2 = false>
__device__ __forceinline__ void gemm_phase(PG8_LAS unsigned char* lds, const Gemm g, const Sched& S, const Epi& E) {
    int tid_l = threadIdx.x; asm volatile("" : "+v"(tid_l));
    const int tid = tid_l, wid = __builtin_amdgcn_readfirstlane(tid >> 6), lane = tid & 63, wr = wid >> 2, wc = wid & 3, fr = lane & 15, fq = lane >> 4;
    int K_l = g.K; asm volatile("" : "+s"(K_l)); const int K = K_l, nt = K / BK;
    unsigned voffA[2], voffB[2];
#pragma unroll
    for (int i = 0; i < 2; ++i) { int R, C; stage_rc(tid * 16 + i * 8192, R, C); const int Rb = Epi::PERM ? ((R & ~31) + perm32(R & 31)) : R;
        voffA[i] = (unsigned)(R * K + C) * 2u; voffB[i] = (unsigned)(Rb * K + C) * 2u; }
    const size_t kstep = (size_t)(BK * 2);
    const size_t hstep = (size_t)HALF * K * 2;
    const size_t tstep = 2 * hstep;
    const unsigned ldsw = (unsigned)wid * 1024u;
    const int aoff = lds_byte(wr * 64 + fr, fq * 8), boff = lds_byte(wc * 32 + fr, fq * 8);
#define PG8_SA(b, h) (((b) * 2 + (h)) * HTB)
#define PG8_SB(b, h) ((4 + (b) * 2 + (h)) * HTB)
#define PG8_STAGE(bufoff, gbase, voff) do { _Pragma("unroll") for (int _i = 0; _i < 2; ++_i) \
        __builtin_amdgcn_global_load_lds((const unsigned*)((const char*)(gbase) + (voff)[_i]), (PG8_LAS unsigned*)(lds + (bufoff) + ldsw + _i * 8192), 16, 0, 0); } while (0)
#define PG8_LDA(dst, b, h) do { _Pragma("unroll") for (int m = 0; m < 4; ++m) _Pragma("unroll") for (int k = 0; k < 2; ++k) dst[m][k] = *(const PG8_LAS bf16x8*)(lds + PG8_SA(b, h) + aoff + m * 2048 + k * 1024); } while (0)
#define PG8_LDB(dst, b, h) do { _Pragma("unroll") for (int n = 0; n < 2; ++n) _Pragma("unroll") for (int k = 0; k < 2; ++k) dst[n][k] = *(const PG8_LAS bf16x8*)(lds + PG8_SB(b, h) + boff + n * 2048 + k * 1024); } while (0)
#define PG8_MMA(ai, bj, At, Bt) do { __builtin_amdgcn_s_setprio(1); _Pragma("unroll") for (int m = 0; m < 4; ++m) _Pragma("unroll") for (int n = 0; n < 2; ++n) _Pragma("unroll") for (int k = 0; k < 2; ++k) \
        acc[ai][bj][m][n] = __builtin_amdgcn_mfma_f32_16x16x32_bf16(Bt[n][k], At[m][k], acc[ai][bj][m][n], 0, 0, 0); __builtin_amdgcn_s_setprio(0); } while (0)
#define PG8_WAIT_V(n) asm volatile("s_waitcnt vmcnt(" #n ")" ::: "memory")
#define PG8_WAIT_L(n) asm volatile("s_waitcnt lgkmcnt(" #n ")" ::: "memory")
#define PG8_BAR __builtin_amdgcn_s_barrier()
#define PG8_SCHED __builtin_amdgcn_sched_barrier(0)
    Unit cur, nxt; int ui = 0;
    if (!S.next(0, cur)) return;
    f32x4 acc[2][2][4][2];
#pragma unroll
    for (int a = 0; a < 2; ++a)
#pragma unroll
        for (int b = 0; b < 2; ++b)
#pragma unroll
            for (int m = 0; m < 4; ++m)
#pragma unroll
                for (int n = 0; n < 2; ++n) acc[a][b][m][n] = (f32x4){0.f, 0.f, 0.f, 0.f};
    bf16x8 At[4][2], B0[2][2], B1[2][2];
    const char* cA = (const char*)g.A + (size_t)cur.pm * tstep; const char* cB = (const char*)g.Bt + (size_t)cur.pn * tstep;
    S.a_ready(cur);
    if constexpr (SP2) {
        PG8_STAGE(PG8_SB(0, 0), cB, voffB); PG8_STAGE(PG8_SB(0, 1), cB + hstep, voffB); PG8_STAGE(PG8_SA(0, 0), cA, voffA); PG8_STAGE(PG8_SA(0, 1), cA + hstep, voffA);
        if (wr == 1) PG8_BAR;
        PG8_WAIT_V(2); PG8_BAR;
        PG8_STAGE(PG8_SB(1, 0), cB + kstep, voffB); PG8_STAGE(PG8_SA(1, 0), cA + kstep, voffA); PG8_STAGE(PG8_SB(1, 1), cB + hstep + kstep, voffB);
        PG8_WAIT_V(6); PG8_BAR;
    } else {
        PG8_STAGE(PG8_SB(0, 0), cB, voffB); PG8_STAGE(PG8_SA(0, 0), cA, voffA); PG8_STAGE(PG8_SB(0, 1), cB + hstep, voffB); PG8_STAGE(PG8_SA(0, 1), cA + hstep, voffA);
        if (wr == 1) PG8_BAR;
        PG8_WAIT_V(4); PG8_BAR;
        PG8_STAGE(PG8_SB(1, 0), cB + kstep, voffB); PG8_STAGE(PG8_SA(1, 0), cA + kstep, voffA); PG8_STAGE(PG8_SB(1, 1), cB + hstep + kstep, voffB);
        PG8_WAIT_V(6); PG8_BAR;
    }
    for (;;) {
        const bool has_next = S.next(ui + 1, nxt);
        const char* nA = has_next ? (const char*)g.A + (size_t)nxt.pm * tstep : cA; const char* nB = has_next ? (const char*)g.Bt + (size_t)nxt.pn * tstep : cB;
        for (int t = 0; t < nt; t += 2) {
            const bool last = (t == nt - 2);
            const char* a1 = cA + (size_t)(t + 1) * kstep;
            const char* a2 = last ? nA : cA + (size_t)(t + 2) * kstep; const char* b2 = last ? nB : cB + (size_t)(t + 2) * kstep;
            const char* a3 = a2 + kstep; const char* b3 = b2 + kstep;
            if (last && has_next) S.a_ready(nxt);
            if constexpr (SP2) {
            PG8_LDB(B0, 0, 0); PG8_LDB(B1, 0, 1); PG8_SCHED; PG8_LDA(At, 0, 0); PG8_STAGE(PG8_SA(1, 1), a1 + hstep, voffA);
            PG8_WAIT_V(8); PG8_WAIT_L(0); PG8_BAR; PG8_MMA(0, 0, At, B0); PG8_MMA(0, 1, At, B1); PG8_BAR; PG8_SCHED;
            PG8_LDA(At, 0, 1); PG8_STAGE(PG8_SB(0, 0), b2, voffB); PG8_STAGE(PG8_SB(0, 1), b2 + hstep, voffB); PG8_STAGE(PG8_SA(0, 0), a2, voffA);
            PG8_WAIT_V(8); PG8_WAIT_L(0); PG8_BAR; PG8_MMA(1, 0, At, B0); PG8_MMA(1, 1, At, B1); PG8_BAR; PG8_SCHED;
            PG8_LDB(B0, 1, 0); PG8_LDB(B1, 1, 1); PG8_SCHED; PG8_LDA(At, 1, 0); PG8_STAGE(PG8_SA(0, 1), a2 + hstep, voffA);
            PG8_WAIT_V(8); PG8_WAIT_L(0); PG8_BAR; PG8_MMA(0, 0, At, B0); PG8_MMA(0, 1, At, B1); PG8_BAR; PG8_SCHED;
            PG8_LDA(At, 1, 1); PG8_STAGE(PG8_SB(1, 0), b3, voffB); PG8_STAGE(PG8_SB(1, 1), b3 + hstep, voffB); PG8_STAGE(PG8_SA(1, 0), a3, voffA);
            PG8_WAIT_V(8); PG8_WAIT_L(0); PG8_BAR; PG8_MMA(1, 0, At, B0); PG8_MMA(1, 1, At, B1); PG8_BAR; PG8_SCHED;
            } else {
            PG8_LDB(B0, 0, 0); PG8_SCHED; PG8_LDA(At, 0, 0); PG8_STAGE(PG8_SA(1, 1), a1 + hstep, voffA);
            PG8_WAIT_L(8); PG8_BAR; PG8_WAIT_L(0); PG8_MMA(0, 0, At, B0); PG8_BAR; PG8_SCHED;
            PG8_LDB(B1, 0, 1); PG8_STAGE(PG8_SB(0, 0), b2, voffB);
            PG8_BAR; PG8_WAIT_L(0); PG8_MMA(0, 1, At, B1); PG8_BAR;
            PG8_LDA(At, 0, 1); PG8_STAGE(PG8_SA(0, 0), a2, voffA);
            PG8_BAR; PG8_WAIT_L(0); PG8_MMA(1, 0, At, B0); PG8_BAR; PG8_SCHED;
            PG8_STAGE(PG8_SB(0, 1), b2 + hstep, voffB);
            PG8_WAIT_V(6); PG8_BAR; PG8_MMA(1, 1, At, B1); PG8_BAR;
            PG8_LDB(B0, 1, 0); PG8_SCHED; PG8_LDA(At, 1, 0); PG8_STAGE(PG8_SA(0, 1), a2 + hstep, voffA);
            PG8_WAIT_L(8); PG8_BAR; PG8_WAIT_L(0); PG8_MMA(0, 0, At, B0); PG8_BAR; PG8_SCHED;
            PG8_LDB(B1, 1, 1); PG8_STAGE(PG8_SB(1, 0), b3, voffB);
            PG8_BAR; PG8_WAIT_L(0); PG8_MMA(0, 1, At, B1); PG8_BAR;
            PG8_LDA(At, 1, 1); PG8_STAGE(PG8_SA(1, 0), a3, voffA);
            PG8_BAR; PG8_WAIT_L(0); PG8_MMA(1, 0, At, B0); PG8_BAR; PG8_SCHED;
            PG8_STAGE(PG8_SB(1, 1), b3 + hstep, voffB);
            PG8_WAIT_V(6); PG8_BAR; PG8_MMA(1, 1, At, B1); PG8_BAR;
            }
        }
        if constexpr (ALIGN_EPI) { if (wr == 0) PG8_BAR; }
        if constexpr (!Epi::AFTER_DRAIN) { E(acc, cur, wr, wc, fr, fq); S.done(cur); }
        if (!has_next) break;
#pragma unroll
        for (int a = 0; a < 2; ++a)
#pragma unroll
            for (int b = 0; b < 2; ++b)
#pragma unroll
                for (int m = 0; m < 4; ++m)
#pragma unroll
                    for (int n = 0; n < 2; ++n) acc[a][b][m][n] = (f32x4){0.f, 0.f, 0.f, 0.f};
        cur = nxt; cA = nA; cB = nB; ++ui;
        if constexpr (ALIGN_EPI) { if (wr == 1) PG8_BAR; }
    }
    PG8_WAIT_V(0);
    if constexpr (!ALIGN_EPI) { if (wr == 0) PG8_BAR; }
    PG8_BAR;
    if constexpr (Epi::AFTER_DRAIN) { E.fused(acc, cur, wr, wc, fr, fq, lds, wid, lane); S.done(cur); }
#undef PG8_SA
#undef PG8_SB
#undef PG8_STAGE
#undef PG8_LDA
#undef PG8_LDB
#undef PG8_MMA
#undef PG8_WAIT_V
#undef PG8_WAIT_L
#undef PG8_BAR
#undef PG8_SCHED
}
}
namespace attn_body {
using bf16=__hip_bfloat16;
using bf16x8=__attribute__((ext_vector_type(8)))short;
using s16x4=__attribute__((ext_vector_type(4)))short;
using f32x16=__attribute__((ext_vector_type(16)))float;
using u32x4=__attribute__((ext_vector_type(4)))unsigned;
constexpr int BATCH=32,NHEAD=8,SEQ=2048,D=64,DM=NHEAD*D,OP=1024;
constexpr int NW=8,QBLK=32,QB=QBLK*NW,KVBLK=64,NQB=SEQ/QB;
constexpr int ATTN_PITCH=DM, ATTN_UNIT_ROWS=QB;
__device__ __forceinline__ int crow(int r,int hi){return (r&3)+8*(r>>2)+4*hi;}
#define SBAR() __builtin_amdgcn_sched_barrier(0)
__device__ __forceinline__ void cmask(f32x16&p0,f32x16&p1,int jb,int qrel,int hi){
  const float NEG=-INFINITY; int kb=64*jb+4*hi;
  #pragma unroll
  for(int r=0;r<16;++r){int kv=kb+(r&3)+8*(r>>2); if(kv>qrel)p0[r]=NEG; if(kv+32>qrel)p1[r]=NEG;}
}

constexpr int NSLOT=3, SLOTB=8192;
constexpr int LDS_K=0, LDS_V=NSLOT*SLOTB, LDS_WS=2*NSLOT*SLOTB, LDS_OST=LDS_WS+NW*64*4, LDS_BYTES=LDS_OST+NW*4096;
constexpr float C2=0.125f*1.4426950408889634f;
__device__ __forceinline__ void glds16(const void*gsrc,unsigned lds_dst){unsigned keep;
  asm volatile("s_mov_b32 %0, m0\n\ts_mov_b32 m0, %2\n\ts_nop 0\n\tglobal_load_lds_dwordx4 %1, off\n\ts_mov_b32 m0, %0":"=&s"(keep):"v"(gsrc),"s"(lds_dst):"memory");}
__device__ __forceinline__ float max3f(float a,float b,float c){float r;asm("v_max3_f32 %0, %1, %2, %3":"=v"(r):"v"(a),"v"(b),"v"(c));return r;}
__device__ __forceinline__ float max2f(float a,float b){float r;asm("v_max_f32_e32 %0, %1, %2":"=v"(r):"v"(a),"v"(b));return r;}
__device__ __forceinline__ float fadd_s(float a,float b){float r;asm("v_add_f32_e32 %0, %1, %2":"=v"(r):"v"(a),"v"(b));return r;}
__device__ __forceinline__ float fsub_s(float a,float b){float r;asm("v_sub_f32_e32 %0, %1, %2":"=v"(r):"v"(a),"v"(b));return r;}
typedef float f32x2_t __attribute__((ext_vector_type(2))); typedef __bf16 bf16x2_t __attribute__((ext_vector_type(2)));
__device__ __forceinline__ unsigned cvtpk_s(float lo,float hi){f32x2_t v={lo,hi};bf16x2_t b=__builtin_convertvector(v,bf16x2_t);return __builtin_bit_cast(unsigned,b);}
#define WAIT_BAR(N) asm volatile("s_waitcnt vmcnt(" #N ") lgkmcnt(0)\n\ts_barrier":::"memory")

__device__ __forceinline__ void qkt(f32x16&p0,f32x16&p1,const char*Kslot,const bf16x8*qr,const f32x16&negm,int r32,int hi){
  const char*kb=Kslot+hi*1024+r32*16;
  #pragma unroll
  for(int d0=0;d0<4;++d0){
    const bf16x8 b0=*reinterpret_cast<const bf16x8*>(kb+d0*2048);
    const bf16x8 b1=*reinterpret_cast<const bf16x8*>(kb+d0*2048+512);
    if(d0==0){p0=__builtin_amdgcn_mfma_f32_32x32x16_bf16(b0,qr[0],negm,0,0,0);p1=__builtin_amdgcn_mfma_f32_32x32x16_bf16(b1,qr[0],negm,0,0,0);}
    else{p0=__builtin_amdgcn_mfma_f32_32x32x16_bf16(b0,qr[d0],p0,0,0,0);p1=__builtin_amdgcn_mfma_f32_32x32x16_bf16(b1,qr[d0],p1,0,0,0);}}
}
typedef __attribute__((address_space(3))) const char* lds_cptr;
typedef short v4i16_t __attribute__((ext_vector_type(4)));
__device__ __forceinline__ void kload8(bf16x8*kf,lds_cptr kp){
  kf[0]=*(const __attribute__((address_space(3))) bf16x8*)(kp);      kf[1]=*(const __attribute__((address_space(3))) bf16x8*)(kp+512);
  kf[2]=*(const __attribute__((address_space(3))) bf16x8*)(kp+2048); kf[3]=*(const __attribute__((address_space(3))) bf16x8*)(kp+2560);
  kf[4]=*(const __attribute__((address_space(3))) bf16x8*)(kp+4096); kf[5]=*(const __attribute__((address_space(3))) bf16x8*)(kp+4608);
  kf[6]=*(const __attribute__((address_space(3))) bf16x8*)(kp+6144); kf[7]=*(const __attribute__((address_space(3))) bf16x8*)(kp+6656);
}
__device__ __forceinline__ void kload2(bf16x8*kf,lds_cptr kp,int j){ kf[2*j]=*(const __attribute__((address_space(3))) bf16x8*)(kp+j*2048); kf[2*j+1]=*(const __attribute__((address_space(3))) bf16x8*)(kp+j*2048+512); }
__device__ __forceinline__ s16x4 vtr(lds_cptr p){ return __builtin_bit_cast(s16x4,__builtin_amdgcn_ds_read_tr16_b64_v4i16((__attribute__((address_space(3))) v4i16_t*)p)); }
__device__ __forceinline__ float rowmax(const f32x16&p0,const f32x16&p1){
  float a=max3f(p0[0],p0[1],p1[0]),b=max3f(p0[2],p0[3],p1[1]);a=max3f(a,p1[2],p1[3]);
  #pragma unroll
  for(int r=4;r<16;r+=4){a=max3f(a,p0[r],p0[r+1]);b=max3f(b,p0[r+2],p0[r+3]);a=max3f(a,p1[r],p1[r+1]);b=max3f(b,p1[r+2],p1[r+3]);}
  const float m=max2f(a,b);
  auto rr=__builtin_amdgcn_permlane32_swap(__float_as_uint(m),__float_as_uint(m),false,false);
  return max2f(__uint_as_float(rr[0]),__uint_as_float(rr[1]));
}
__device__ __forceinline__ void pv(f32x16*o,int vb,bf16x8 pa0,bf16x8 pa1,bf16x8 pa2,bf16x8 pa3){
  #pragma unroll
  for(int d0=0;d0<2;++d0){s16x4 lo[4],hi[4];
    #pragma unroll
    for(int ks=0;ks<4;++ks){
      asm volatile("ds_read_b64_tr_b16 %0,%1 offset:%c2":"=&v"(lo[ks]):"v"(vb),"i"(d0*4096+ks*1024):"memory");
      asm volatile("ds_read_b64_tr_b16 %0,%1 offset:%c2":"=&v"(hi[ks]):"v"(vb),"i"(d0*4096+ks*1024+512):"memory");}
    asm volatile("s_waitcnt lgkmcnt(0)":::"memory");SBAR();
    #define PK(k) (bf16x8){lo[k][0],lo[k][1],lo[k][2],lo[k][3],hi[k][0],hi[k][1],hi[k][2],hi[k][3]}
    o[d0]=__builtin_amdgcn_mfma_f32_32x32x16_bf16(pa0,PK(0),o[d0],0,0,0);
    o[d0]=__builtin_amdgcn_mfma_f32_32x32x16_bf16(pa1,PK(1),o[d0],0,0,0);
    o[d0]=__builtin_amdgcn_mfma_f32_32x32x16_bf16(pa2,PK(2),o[d0],0,0,0);
    o[d0]=__builtin_amdgcn_mfma_f32_32x32x16_bf16(pa3,PK(3),o[d0],0,0,0);
    #undef PK
  }
}

#ifndef ATTN_STORE16
#define ATTN_STORE16(p,v) (*(u32x4*)(p)=(v))
#endif
typedef float f32x4_t __attribute__((ext_vector_type(4)));
typedef const __attribute__((address_space(3))) float* lds_cfptr;
#define BIAS(P0,P1,t) do{ const __attribute__((address_space(3))) f32x4_t* bp_=(const __attribute__((address_space(3))) f32x4_t*)(biasL+(t)*64+4*hi); \
  _Pragma("unroll") for(int g_=0;g_<4;++g_){ const f32x4_t b0_=bp_[2*g_], b1_=bp_[2*g_+8]; \
    _Pragma("unroll") for(int i_=0;i_<4;++i_){ P0[4*g_+i_]+=b0_[i_]; P1[4*g_+i_]+=b1_[i_]; } } }while(0)
template<int THRL> __device__ __forceinline__ void attn_unit(int b,int h,int qb,const bf16*Q,const bf16*__restrict__ K,const bf16*__restrict__ V,bf16*O,char*shm,lds_cfptr biasL){
  int tid_l=threadIdx.x; asm volatile("":"+v"(tid_l)); const int tid=tid_l,lane=tid&63,r32=lane&31,hi=lane>>5; const int wid=__builtin_amdgcn_readfirstlane(tid>>6);
  const long rowbase=(long)b*SEQ; const int q0=qb*QB;
  const bf16*Qw=Q+(rowbase+q0+wid*QBLK)*DM+h*D;
  const bf16*Kh=K+rowbase*DM+h*D,*Vh=V+rowbase*DM+h*D;
  const unsigned lds0=(unsigned)(uintptr_t)shm;
  float*wsf=(float*)(shm+LDS_WS)+wid*64;
  const bf16*ksrc=Kh+(long)lane*DM+wid*8;
  const bf16*vsrc=Vh+(long)(16*(wid&3)+(lane>>2))*DM+(wid>>2)*32+(lane&3)*8;
  const unsigned kdst=lds0+LDS_K+wid*1024, vdst=lds0+LDS_V+wid*1024;
  #define DMA_K(t,slot) glds16(ksrc+(long)(t)*KVBLK*DM,(unsigned)__builtin_amdgcn_readfirstlane(kdst+(slot)))
  #define DMA_V(t,slot) glds16(vsrc+(long)(t)*KVBLK*DM,(unsigned)__builtin_amdgcn_readfirstlane(vdst+(slot)))
  const int vb0=(int)(lds0+LDS_V)+((lane>>4)&1)*32+(lane&3)*8+(4*hi+((lane&15)>>2))*64;
  const char*Kbase=shm+LDS_K; bf16x8 kf[8];
  const lds_cptr shm3=(lds_cptr)shm; const lds_cptr kp0=shm3+LDS_K+hi*1024+r32*16; const lds_cptr vp0=shm3+LDS_V+((lane>>4)&1)*32+(lane&3)*8+(4*hi+((lane&15)>>2))*64;
  const int NT=(q0+QB)/KVBLK;
  DMA_K(0,0);DMA_V(0,0);DMA_K(1,SLOTB);
  bf16x8 qr[4];
  #pragma unroll
  for(int d0=0;d0<4;++d0)qr[d0]=*reinterpret_cast<const bf16x8*>(&Qw[(long)r32*DM+d0*16+hi*8]);
  float mhat=0.f,l_reg=0.f;f32x16 o[2];f32x16 negm; { float z_=0.f; asm volatile("":"+v"(z_)); _Pragma("unroll") for(int r=0;r<16;++r){o[0][r]=z_;o[1][r]=z_;negm[r]=z_;} }     asm volatile("":"+v"(negm));
  const int qrel=wid*QBLK+r32;
  #define CMASK(P0,P1,t) do{int jb_=(t)-(NT-4); if(jb_>=0)cmask(P0,P1,jb_,qrel,hi);}while(0)
  bool resc=false;
  #define START(P0,P1) do{ const float rm=rowmax(P0,P1); resc=false; \
    { const float dl=rm; mhat=fadd_s(mhat,dl); \
      _Pragma("unroll") for(int r=0;r<16;++r){P0[r]=fsub_s(P0[r],dl);P1[r]=fsub_s(P1[r],dl);} \
      _Pragma("unroll") for(int r=0;r<16;++r)negm[r]=-mhat; asm volatile("":"+v"(negm)); } \
    _Pragma("unroll") for(int r=0;r<16;++r)P0[r]=__builtin_amdgcn_exp2f(P0[r]); }while(0)
  #define RESC() do{ if(resc){ asm volatile("s_waitcnt lgkmcnt(0)":::"memory"); \
      _Pragma("unroll") for(int d_=0;d_<2;++d_) _Pragma("unroll") for(int r=0;r<16;++r)o[d_][r]*=wsf[crow(r,hi)]; } }while(0)
  f32x16 pA0,pA1,pB0,pB1;
  int sl_prev=0,sl_cur=0,sl_next=SLOTB;
  #define ROT() do{sl_prev=sl_cur;sl_cur=sl_next;sl_next=(sl_next==(NSLOT-1)*SLOTB)?0:sl_next+SLOTB;}while(0)
  DMA_K(2,2*SLOTB);
  WAIT_BAR(3);
  qkt(pA0,pA1,Kbase,qr,negm,r32,hi);asm volatile("s_nop 15\n\ts_nop 7":"+v"(pA0),"+v"(pA1));BIAS(pA0,pA1,0);CMASK(pA0,pA1,0);
  START(pA0,pA1);
  _Pragma("unroll") for(int r=0;r<16;++r)pA1[r]=__builtin_amdgcn_exp2f(pA1[r]);
  WAIT_BAR(0);
  DMA_K(3,0);DMA_V(1,SLOTB);
  ROT();
  kload8(kf,kp0+sl_cur);
  WAIT_BAR(2);
  s16x4 vlo[8],vhi[8]; u32x4 pw0,pw1,pw2,pw3;
  #define PKW(P,B) cvtpk_s(P[B],P[B+1])
  #define PAF(k) __builtin_bit_cast(bf16x8,pw##k)
  #define VFR(i) (bf16x8){vlo[i][0],vlo[i][1],vlo[i][2],vlo[i][3],vhi[i][0],vhi[i][1],vhi[i][2],vhi[i][3]}
  #define PIN(x) asm volatile("":"+v"(x))
  #define MX3(a,b,c) __builtin_fmaxf(__builtin_fmaxf((a),(b)),(c))
  #define GAPA(MF,A0,A1,A2,A3,W0,W1,PW) do{ MF; sacc+=A0; sacc+=A1; sacc+=A2; sacc+=A3; PIN(sacc); W0; W1; PIN(PW); SBAR(); }while(0)
  #define EX(v) __builtin_amdgcn_exp2f(v)
  #define GAPB(MF,X,B) do{ MF; X[B]=EX(X[B]); X[B+1]=EX(X[B+1]); X[B+2]=EX(X[B+2]); X[B+3]=EX(X[B+3]); PIN(X); SBAR(); }while(0)
  #define VRD(i) do{ vlo[i]=vtr(vp_+(((i)>>2)*4096+((i)&3)*1024)); vhi[i]=vtr(vp_+(((i)>>2)*4096+((i)&3)*1024+512)); }while(0)
  #define KRD(G,j) do{ if(G){ kload2(kf,kp0+sl_next,j); SBAR(); } }while(0)
  #define STEP(C0,C1,P0,P1,t,GK,GV,GL) do{ SBAR(); \
    const lds_cptr vp_=vp0+sl_prev; \
    VRD(0); SBAR(); float sacc=(P0[0]+P0[1]); \
    GAPA(C0=__builtin_amdgcn_mfma_f32_32x32x16_bf16(kf[0],qr[0],negm,0,0,0), P0[2],P0[3],P0[4],P0[5],     pw0[0]=PKW(P0,0), pw0[1]=PKW(P0,2), pw0); \
    VRD(4); SBAR(); GAPA(C1=__builtin_amdgcn_mfma_f32_32x32x16_bf16(kf[1],qr[0],negm,0,0,0), P0[6],P0[7],P0[8],P0[9],     pw0[2]=PKW(P0,4), pw0[3]=PKW(P0,6), pw0); \
    VRD(1); SBAR(); GAPA(C0=__builtin_amdgcn_mfma_f32_32x32x16_bf16(kf[2],qr[1],C0,0,0,0),   P0[10],P0[11],P0[12],P0[13], pw1[0]=PKW(P0,8), pw1[1]=PKW(P0,10), pw1); \
    VRD(5); SBAR(); GAPA(C1=__builtin_amdgcn_mfma_f32_32x32x16_bf16(kf[3],qr[1],C1,0,0,0),   P0[14],P0[15],P1[0],P1[1],   pw1[2]=PKW(P0,12),pw1[3]=PKW(P0,14), pw1); \
    VRD(2); SBAR(); GAPA(C0=__builtin_amdgcn_mfma_f32_32x32x16_bf16(kf[4],qr[2],C0,0,0,0),   P1[2],P1[3],P1[4],P1[5],     pw2[0]=PKW(P1,0), pw2[1]=PKW(P1,2), pw2); \
    VRD(6); SBAR(); GAPA(C1=__builtin_amdgcn_mfma_f32_32x32x16_bf16(kf[5],qr[2],C1,0,0,0),   P1[6],P1[7],P1[8],P1[9],     pw2[2]=PKW(P1,4), pw2[3]=PKW(P1,6), pw2); \
    VRD(3); SBAR(); GAPA(C0=__builtin_amdgcn_mfma_f32_32x32x16_bf16(kf[6],qr[3],C0,0,0,0),   P1[10],P1[11],P1[12],P1[13], pw3[0]=PKW(P1,8), pw3[1]=PKW(P1,10), pw3); \
    VRD(7); SBAR(); GAPA(C1=__builtin_amdgcn_mfma_f32_32x32x16_bf16(kf[7],qr[3],C1,0,0,0),   P1[14],P1[15],0.f,0.f,       pw3[2]=PKW(P1,12),pw3[3]=PKW(P1,14), pw3); \
    l_reg+=sacc; \
    if(GK){DMA_K((t)+3,sl_cur);} if(GV){DMA_V((t)+1,sl_next);} \
    BIAS(C0,C1,t); CMASK(C0,C1,t); \
    { float a=MX3(C0[0],C0[1],C1[0]),b=MX3(C0[2],C0[3],C1[1]); a=MX3(a,C1[2],C1[3]); \
      _Pragma("unroll") for(int r=4;r<16;r+=4){a=MX3(a,C0[r],C0[r+1]);b=MX3(b,C0[r+2],C0[r+3]);a=MX3(a,C1[r],C1[r+1]);b=MX3(b,C1[r+2],C1[r+3]);} \
      float rm=__builtin_fmaxf(a,b); { auto rr=__builtin_amdgcn_permlane32_swap(__float_as_uint(rm),__float_as_uint(rm),false,false); rm=__builtin_fmaxf(__uint_as_float(rr[0]),__uint_as_float(rr[1])); } \
      resc=false; \
      if(__builtin_expect(__any(rm>(float)THRL),0)){ const float dl=__builtin_fmaxf(rm,0.f); mhat+=dl; \
        _Pragma("unroll") for(int r=0;r<16;++r){C0[r]-=dl;C1[r]-=dl;} \
        _Pragma("unroll") for(int r=0;r<16;++r)negm[r]=-mhat; asm volatile("":"+v"(negm)); \
        const float f=__builtin_amdgcn_exp2f(-dl); l_reg*=f; if(hi==0)wsf[r32]=f; resc=true; } } \
    SBAR(); \
    GAPB(o[0]=__builtin_amdgcn_mfma_f32_32x32x16_bf16(PAF(0),VFR(0),o[0],0,0,0), C0,0); \
    GAPB(o[1]=__builtin_amdgcn_mfma_f32_32x32x16_bf16(PAF(0),VFR(4),o[1],0,0,0), C0,4); \
    KRD(GL,0); GAPB(o[0]=__builtin_amdgcn_mfma_f32_32x32x16_bf16(PAF(1),VFR(1),o[0],0,0,0), C0,8); \
    KRD(GL,1); GAPB(o[1]=__builtin_amdgcn_mfma_f32_32x32x16_bf16(PAF(1),VFR(5),o[1],0,0,0), C0,12); \
    KRD(GL,2); GAPB(o[0]=__builtin_amdgcn_mfma_f32_32x32x16_bf16(PAF(2),VFR(2),o[0],0,0,0), C1,0); \
    KRD(GL,3); GAPB(o[1]=__builtin_amdgcn_mfma_f32_32x32x16_bf16(PAF(2),VFR(6),o[1],0,0,0), C1,4); \
    GAPB(o[0]=__builtin_amdgcn_mfma_f32_32x32x16_bf16(PAF(3),VFR(3),o[0],0,0,0), C1,8); \
    GAPB(o[1]=__builtin_amdgcn_mfma_f32_32x32x16_bf16(PAF(3),VFR(7),o[1],0,0,0), C1,12); \
    }while(0)
  int t=1;
  #undef CMASK
  #define CMASK(P0,P1,t) do{}while(0)
  for(;t+5<NT;t+=2){
    STEP(pB0,pB1,pA0,pA1,t,true,true,true);     WAIT_BAR(2); RESC(); ROT();
    STEP(pA0,pA1,pB0,pB1,t+1,true,true,true);   WAIT_BAR(2); RESC(); ROT();
  }
  #undef CMASK
  #define CMASK(P0,P1,t) do{int jb_=(t)-(NT-4); if(jb_>=0)cmask(P0,P1,jb_,qrel,hi);}while(0)
  #define ENDW(tt) do{ if((tt)+3<NT){WAIT_BAR(2);} else if((tt)+2<NT){WAIT_BAR(1);} else {WAIT_BAR(0);} }while(0)
  for(;t+1<NT;t+=2){
    STEP(pB0,pB1,pA0,pA1,t,(t+3<NT),(t+1<NT),(t+1<NT));       ENDW(t);   RESC(); ROT();
    STEP(pA0,pA1,pB0,pB1,t+1,(t+4<NT),(t+2<NT),(t+2<NT));     ENDW(t+1); RESC(); ROT();
  }
  STEP(pB0,pB1,pA0,pA1,NT-1,false,false,false); RESC();
  { float sacc=pB0[0]+pB0[1]; _Pragma("unroll") for(int r=2;r<16;++r)sacc+=pB0[r]; _Pragma("unroll") for(int r=0;r<16;++r)sacc+=pB1[r]; l_reg+=sacc;
    pw0=(u32x4){PKW(pB0,0),PKW(pB0,2),PKW(pB0,4),PKW(pB0,6)};pw1=(u32x4){PKW(pB0,8),PKW(pB0,10),PKW(pB0,12),PKW(pB0,14)};pw2=(u32x4){PKW(pB1,0),PKW(pB1,2),PKW(pB1,4),PKW(pB1,6)};pw3=(u32x4){PKW(pB1,8),PKW(pB1,10),PKW(pB1,12),PKW(pB1,14)};
    SBAR(); pv(o,vb0+sl_cur,PAF(0),PAF(1),PAF(2),PAF(3)); }
  #undef PKW
  #undef PAF
  #undef VFR
  #undef PIN
  #undef MX3
  #undef GAPA
  #undef GAPB
  #undef EX
  #undef VRD
  #undef KRD
  #undef STEP
  #undef ENDW
  {auto rr=__builtin_amdgcn_permlane32_swap(__float_as_uint(l_reg),__float_as_uint(l_reg),false,false);l_reg=__uint_as_float(rr[0])+__uint_as_float(rr[1]);}
  if(hi==0)wsf[32+r32]=l_reg;asm volatile("s_waitcnt lgkmcnt(0)":::"memory");
  float rli[16];
  #pragma unroll
  for(int r=0;r<16;++r)rli[r]=__builtin_amdgcn_rcpf(wsf[32+crow(r,hi)]);
  bf16*Ow=O+(rowbase+q0+wid*QBLK)*OP+h*D;
  { bf16*stg=(bf16*)(shm+LDS_OST)+wid*2048;
    #pragma unroll
    for(int r=0;r<16;++r){const int orow=crow(r,hi);
      #pragma unroll
      for(int d0=0;d0<2;++d0)stg[orow*64+d0*32+r32]=__float2bfloat16(o[d0][r]*rli[r]);}
    asm volatile("s_waitcnt lgkmcnt(0)":::"memory");
    #pragma unroll
    for(int i=0;i<4;++i){const int row=i*8+(lane>>3),ch=lane&7; const u32x4 v=*(const u32x4*)(stg+row*64+ch*8); ATTN_STORE16(Ow+(long)row*OP+ch*8,v);} }
  asm volatile("s_waitcnt lgkmcnt(0)\n\ts_barrier":::"memory");
  #undef DMA_K
  #undef DMA_V
  #undef CMASK
  #undef START
  #undef RESC
  #undef ROT
}
constexpr int ATTN_LDS_BYTES=LDS_BYTES;
struct AttnTensors { const bf16* Q; const bf16* K; const bf16* V; bf16* O; };
struct AttnUnit { int bh; int qb; };
struct StaticOrder {
  int vcu;
  __device__ __forceinline__ explicit StaticOrder(int v):vcu(v){}
  __device__ __forceinline__ bool next(int i,AttnUnit&u)const{ if(i>=8)return false; u.bh=vcu; u.qb=(i&1)?(i>>1):7-(i>>1); return true; }
  __device__ __forceinline__ void a_ready(const AttnUnit&)const{}
  __device__ __forceinline__ void done(const AttnUnit&)const{}
};
template<class Sched,int THRL=60> __device__ __forceinline__ void attn_phase(char*lds,const AttnTensors&T,const Sched&S,lds_cfptr biasL){
  AttnUnit u;
  for(int i=0;S.next(i,u);++i){ S.a_ready(u); attn_unit<THRL>(u.bh/NHEAD,u.bh%NHEAD,u.qb,T.Q,T.K,T.V,T.O,lds,biasL); S.done(u); }
}
#undef BIAS
#undef SBAR
#undef WAIT_BAR
}
#define GAS __attribute__((address_space(1)))
#define LAS __attribute__((address_space(3)))
typedef unsigned short bf16;
typedef unsigned v4u __attribute__((ext_vector_type(4)));
typedef float f32x4 __attribute__((ext_vector_type(4)));
typedef short bf16x8 __attribute__((ext_vector_type(8)));
typedef GAS unsigned gu32;
typedef GAS unsigned long long gu64;
#define RLX_AGENT __ATOMIC_RELAXED, __HIP_MEMORY_SCOPE_AGENT
#define LDS_WAIT() asm volatile("s_waitcnt lgkmcnt(0)" ::: "memory")
#define VM_WAIT() asm volatile("s_waitcnt vmcnt(0)" ::: "memory")
__device__ __forceinline__ unsigned long long rt() { return __builtin_amdgcn_s_memrealtime(); }
__device__ __forceinline__ unsigned f2bf(float f) { unsigned u = __builtin_bit_cast(unsigned, f); return (u + 0x7fffu + ((u >> 16) & 1u)) >> 16; }
__device__ __forceinline__ unsigned pk2(float lo, float hi) { return f2bf(lo) | (f2bf(hi) << 16); }
#define XB_TMO      128
#define XB_XCNT(j)  (256  + 64 * (j))
#define XB_XSUB(j)  (1280 + 64 * (j))
#define XB_XGEN(j)  (2304 + 64 * (j))
#define XB_TOP      3328
#define XB_TOPGEN   3392
#define XCD_BAR_WORDS 3456
#define XB_SPIN_CAP (1u << 18)

__device__ __forceinline__ unsigned xb_ld(unsigned* p)              { return __hip_atomic_load(p, __ATOMIC_RELAXED, __HIP_MEMORY_SCOPE_AGENT); }
__device__ __forceinline__ unsigned xb_add(unsigned* p, unsigned v) { return __hip_atomic_fetch_add(p, v, __ATOMIC_RELAXED, __HIP_MEMORY_SCOPE_AGENT); }
__device__ __forceinline__ unsigned xb_xcc_id() { return (unsigned)__builtin_amdgcn_s_getreg((3 << 11) | 20) & 0xFu; }
#define XB_SPIN(cond, bar) do { unsigned _sp = 0; while (cond) { __builtin_amdgcn_s_sleep(1); \
    if ((++_sp & 255u) == 0u) { if (xb_ld(&(bar)[XB_TMO])) break; if (_sp > XB_SPIN_CAP) { atomicAdd(&(bar)[XB_TMO], 1u); break; } } } } while (0)

struct XcdBarrier {
    unsigned* bar; unsigned x;
    volatile LAS unsigned* st;
};

__device__ __forceinline__ XcdBarrier xcd_barrier_post(unsigned* bar, volatile LAS unsigned* st) {
    XcdBarrier b; b.bar = bar; b.x = xb_xcc_id(); b.st = st;
    if (threadIdx.x == 0) (void)xb_add(&bar[XB_XCNT(b.x)], 1u);
    return b;
}
__device__ __forceinline__ void xcd_barrier_complete(unsigned* bar, unsigned x, unsigned& nloc, unsigned& nx) {
    const unsigned G = gridDim.x * gridDim.y * gridDim.z;
    unsigned sum, cnt, mine, sp = 0u;
    for (;;) {
        sum = 0u; cnt = 0u; mine = 0u;
#pragma unroll
        for (unsigned j = 0; j < 16; ++j) { const unsigned c = xb_ld(&bar[XB_XCNT(j)]); sum += c; cnt += (c > 0u) ? 1u : 0u; mine = (j == x) ? c : mine; }
        if (sum == G) break;
        __builtin_amdgcn_s_sleep(1);
        if ((++sp & 255u) == 0u) { if (xb_ld(&bar[XB_TMO])) break; if (sp > XB_SPIN_CAP) { atomicAdd(&bar[XB_TMO], 1u); break; } }
    }
    nloc = mine > 0u ? mine : 1u; nx = cnt > 0u ? cnt : 1u;
}

__device__ __forceinline__ void xcd_barrier(const XcdBarrier& b) {
    asm volatile("s_waitcnt vmcnt(0)" ::: "memory");
    __syncthreads();
    if (threadIdx.x == 0) {
        unsigned* bar = b.bar;
        __builtin_amdgcn_s_waitcnt(0);
        unsigned nloc = b.st[0], nx = b.st[1];
        if (nloc == 0u) { xcd_barrier_complete(bar, b.x, nloc, nx); b.st[0] = nloc; b.st[1] = nx; }
        const unsigned old = xb_add(&bar[XB_XSUB(b.x)], 1u);
        const unsigned gen = old / nloc;
        if (old + 1u == (gen + 1u) * nloc) {
            __builtin_amdgcn_fence(__ATOMIC_RELEASE, "agent");
            asm volatile("s_waitcnt vmcnt(0)" ::: "memory");
            const unsigned og = xb_add(&bar[XB_TOP], 1u);
            const unsigned tg = og / nx;
            if (og + 1u == (tg + 1u) * nx) xb_add(&bar[XB_TOPGEN], 1u);
            else XB_SPIN(xb_ld(&bar[XB_TOPGEN]) == tg, bar);
            __builtin_amdgcn_fence(__ATOMIC_ACQUIRE, "agent");
            xb_add(&bar[XB_XGEN(b.x)], 1u);
            asm volatile("s_waitcnt vmcnt(0)" ::: "memory");
        } else {
            XB_SPIN(xb_ld(&bar[XB_XGEN(b.x)]) == gen, bar);
            __builtin_amdgcn_fence(__ATOMIC_ACQUIRE, "agent");
            asm volatile("s_waitcnt vmcnt(0)" ::: "memory");
        }
    }
    __syncthreads();
}
constexpr int DM = 1024, NB = 32, SEQ = 2048, DEPTH = 4, DSEQ = 32, PAST = 2048, NH = 8, HD = 64, DATT = 512, DCONV = 512, DFF = 2816, DIN = 3080;
constexpr int NIN = 3328, NUP = 5632;
constexpr int MP = NB * SEQ, MS = NB * DSEQ, MT = MP + MS;
static_assert(MP == pg8::EP_MP && MT % 256 == 0, "row map");
constexpr float ALPHA = 1.6817928305074290861f;
constexpr float LN_EPS = 1e-5f, LOG2E = 1.4426950408889634f, QSCALE = 0.125f * 1.4426950408889634f;
constexpr int NWAVES = 8;
constexpr size_t OUT_Y = 0, OUT_KP = (size_t)MT * DM, OUT_VP = OUT_KP + (size_t)DEPTH * MP * DATT, OUT_LFP = OUT_VP + (size_t)DEPTH * MP * DATT,
    OUT_MCP = OUT_LFP + (size_t)DEPTH * MP * NH, OUT_FCP = OUT_MCP + (size_t)DEPTH * NB * 2 * DCONV, OUT_KS = OUT_FCP + (size_t)DEPTH * NB * 2 * DFF,
    OUT_VS = OUT_KS + (size_t)DEPTH * MS * DATT, OUT_LFS = OUT_VS + (size_t)DEPTH * MS * DATT, OUT_MCS = OUT_LFS + (size_t)DEPTH * MS * NH,
    OUT_FCS = OUT_MCS + (size_t)DEPTH * NB * 2 * DCONV, OUT_END = OUT_FCS + (size_t)DEPTH * NB * 2 * DFF;
static_assert(OUT_END == 344621056ull, "output size");
constexpr size_t MiB = 1u << 20;
constexpr size_t WS_CTL = 0, CTL_ZERO_BYTES = 1 * MiB;
constexpr size_t W_IN_B = (size_t)NIN * DM * 2, W_OUT_B = (size_t)DM * DM * 2, W_UP_B = (size_t)NUP * DM * 2, W_DN_B = (size_t)DM * DFF * 2, W_LAYER_B = W_IN_B + W_OUT_B + W_UP_B + W_DN_B;
constexpr size_t WS_W = 2 * MiB;
constexpr size_t WS_XN = 104 * MiB;
constexpr size_t WS_Y = 234 * MiB;
constexpr size_t WS_A2 = 494 * MiB;
constexpr size_t WS_R = 852 * MiB;
constexpr size_t ACT512_B = (size_t)MT * 512 * 2, ACT1024_B = (size_t)MT * 1024 * 2, ACTFF_B = (size_t)MT * DFF * 2;
constexpr size_t WS_Q = WS_R, WS_K = WS_Q + ACT512_B, WS_V = WS_K + ACT512_B, WS_BG = WS_V + ACT512_B, WS_U = WS_BG + ACT512_B, WS_AO = WS_U + ACT512_B;
constexpr size_t WS_G = WS_R, WS_VAL = WS_G + ACTFF_B;
constexpr size_t WS_END = 1568 * MiB;
static_assert(WS_W + DEPTH * W_LAYER_B <= WS_XN && WS_XN + ACT1024_B <= WS_Y && WS_Y + (size_t)MT * DM * 4 <= WS_A2 && WS_A2 + ACTFF_B <= WS_R && WS_AO + ACT1024_B <= WS_END && WS_VAL + ACTFF_B <= WS_END, "d_ws map");
constexpr int CW_TMO = 0, CW_CODE = 1, CW_BAR = 4096;
constexpr int RING_OFF = 0, RING_BYTES = 131072;
constexpr int LDSCTL_OFF = RING_BYTES, MISC_OFF = LDSCTL_OFF + 320;
constexpr int LDS_BYTES = 147456;
constexpr int BIAS_OFF = 86016, BIAS_FLOATS = 2080, SCAN_OFF = BIAS_OFF + BIAS_FLOATS * 4;
static_assert(OUT_KP == pg8::EP_OUT_KP && OUT_VP == pg8::EP_OUT_VP && OUT_LFP == pg8::EP_OUT_LFP && OUT_MCP == pg8::EP_OUT_MCP && OUT_FCP == pg8::EP_OUT_FCP && OUT_KS == pg8::EP_OUT_KS && OUT_VS == pg8::EP_OUT_VS && OUT_LFS == pg8::EP_OUT_LFS && OUT_MCS == pg8::EP_OUT_MCS && OUT_FCS == pg8::EP_OUT_FCS, "epilogue output map");
static_assert(WS_Q == pg8::EP_WS_Q && WS_K == pg8::EP_WS_K && WS_V == pg8::EP_WS_V && WS_BG == pg8::EP_WS_BG && WS_U == pg8::EP_WS_U && WS_G == pg8::EP_WS_G && WS_VAL == pg8::EP_WS_VAL, "epilogue workspace map");
static_assert(attn_body::ATTN_LDS_BYTES <= BIAS_OFF && SCAN_OFF + 64 <= RING_BYTES, "LDS map");
typedef unsigned u32x2v __attribute__((ext_vector_type(2)));
typedef float f32x16 __attribute__((ext_vector_type(16)));
__device__ __forceinline__ unsigned cvtpk(float lo, float hi) { return pg8::cvt_pk_bf16(lo, hi); }
__device__ __forceinline__ float bf_lo(unsigned w) { return __uint_as_float(w << 16); }
__device__ __forceinline__ float bf_hi(unsigned w) { return __uint_as_float(w & 0xffff0000u); }
__device__ __forceinline__ float wave_sum(float v) {
#pragma unroll
    for (int o = 1; o < 64; o <<= 1) v += __shfl_xor(v, o);
    return v;
}
__device__ __forceinline__ float wave_incl_scan(float v, int lane) {
#pragma unroll
    for (int o = 1; o < 64; o <<= 1) { const float t = __shfl_up(v, o); if (lane >= o) v += t; }
    return v;
}
__device__ __forceinline__ void transpose_item(const float* W, int ldw, int src0, int nv, int k0, bf16* WT, int K, int n0, LAS float* scr, int lane) {
    const int c = lane & 31;
#pragma unroll 8
    for (int i = 0; i < 32; ++i) { const int kk = 2 * i + (lane >> 5); scr[kk * 33 + c] = c < nv ? W[(size_t)(k0 + kk) * ldw + src0 + c] : 0.f; }
    LDS_WAIT(); asm volatile("" ::: "memory");
    const int c8 = lane & 7;
#pragma unroll
    for (int j = 0; j < 4; ++j) { const int n = (lane >> 3) + 8 * j; const LAS float* s = scr + (8 * c8) * 33 + n;
        v4u o; o.x = cvtpk(s[0 * 33], s[1 * 33]); o.y = cvtpk(s[2 * 33], s[3 * 33]); o.z = cvtpk(s[4 * 33], s[5 * 33]); o.w = cvtpk(s[6 * 33], s[7 * 33]);
        *(GAS v4u*)(WT + (size_t)(n0 + n) * K + k0 + 8 * c8) = o; }
    LDS_WAIT(); asm volatile("" ::: "memory");
}
__device__ __forceinline__ bf16x8 pack8f(const f32x4 a, const f32x4 b) { v4u w; w.x = cvtpk(a[0], a[1]); w.y = cvtpk(a[2], a[3]); w.z = cvtpk(b[0], b[1]); w.w = cvtpk(b[2], b[3]); return __builtin_bit_cast(bf16x8, w); }
__device__ __forceinline__ float half_max(float m) { auto rr = __builtin_amdgcn_permlane32_swap(__float_as_uint(m), __float_as_uint(m), false, false); return fmaxf(__uint_as_float(rr[0]), __uint_as_float(rr[1])); }
__device__ __forceinline__ float half_sum(float m) { auto rr = __builtin_amdgcn_permlane32_swap(__float_as_uint(m), __float_as_uint(m), false, false); return __uint_as_float(rr[0]) + __uint_as_float(rr[1]); }
__device__ __forceinline__ void samp_tile(const float* __restrict__ Kp, const float* __restrict__ Vp, const LAS float* biasp, const bool causal, const bf16x8 (&qr)[4], const int r32, const int hi,
                                          float& m_run, float& l_run, f32x16& o0, f32x16& o1) {
    f32x4 kr[4][2];
    const float* kp = Kp + (size_t)r32 * 512 + hi * 8;
#pragma unroll
    for (int d0 = 0; d0 < 4; ++d0) { kr[d0][0] = *(const f32x4*)(kp + d0 * 16); kr[d0][1] = *(const f32x4*)(kp + d0 * 16 + 4); }
    float vr[2][2][8];
    const float* vp = Vp + (size_t)(4 * hi) * 512 + r32;
#pragma unroll
    for (int s = 0; s < 2; ++s)
#pragma unroll
        for (int i = 0; i < 8; ++i) { const int cc = ((8 * s + i) & 3) + 8 * ((8 * s + i) >> 2);
#pragma unroll
            for (int dh = 0; dh < 2; ++dh) vr[s][dh][i] = vp[(size_t)cc * 512 + dh * 32]; }
    f32x16 S = {};
#pragma unroll
    for (int d0 = 0; d0 < 4; ++d0) S = __builtin_amdgcn_mfma_f32_32x32x16_bf16(pack8f(kr[d0][0], kr[d0][1]), qr[d0], S, 0, 0, 0);
#pragma unroll
    for (int g = 0; g < 4; ++g) { const f32x4 bb = *(const LAS f32x4*)(biasp + 8 * g + 4 * hi);
#pragma unroll
        for (int i = 0; i < 4; ++i) S[4 * g + i] += bb[i]; }
    if (causal) {
#pragma unroll
        for (int r = 0; r < 16; ++r) { const int kv = (r & 3) + 8 * (r >> 2) + 4 * hi; if (kv > r32) S[r] = -INFINITY; }
    }
    float rm = S[0];
#pragma unroll
    for (int r = 1; r < 16; ++r) rm = fmaxf(rm, S[r]);
    rm = half_max(rm);
    const float m_new = fmaxf(m_run, rm), alpha = __builtin_amdgcn_exp2f(m_run - m_new);
    float ls = 0.f;
#pragma unroll
    for (int r = 0; r < 16; ++r) { S[r] = __builtin_amdgcn_exp2f(S[r] - m_new); ls += S[r]; }
    l_run = l_run * alpha + ls; m_run = m_new;
#pragma unroll
    for (int r = 0; r < 16; ++r) { o0[r] *= alpha; o1[r] *= alpha; }
#pragma unroll
    for (int s = 0; s < 2; ++s) {
        const bf16x8 pb = pack8f((f32x4){S[8 * s], S[8 * s + 1], S[8 * s + 2], S[8 * s + 3]}, (f32x4){S[8 * s + 4], S[8 * s + 5], S[8 * s + 6], S[8 * s + 7]});
        const bf16x8 va0 = pack8f((f32x4){vr[s][0][0], vr[s][0][1], vr[s][0][2], vr[s][0][3]}, (f32x4){vr[s][0][4], vr[s][0][5], vr[s][0][6], vr[s][0][7]});
        const bf16x8 va1 = pack8f((f32x4){vr[s][1][0], vr[s][1][1], vr[s][1][2], vr[s][1][3]}, (f32x4){vr[s][1][4], vr[s][1][5], vr[s][1][6], vr[s][1][7]});
        o0 = __builtin_amdgcn_mfma_f32_32x32x16_bf16(va0, pb, o0, 0, 0, 0);
        o1 = __builtin_amdgcn_mfma_f32_32x32x16_bf16(va1, pb, o1, 0, 0, 0);
    }
}
__device__ __forceinline__ void sample_attn_unit(LAS unsigned char* lds, const float* ck, const float* cv, const float* clf, const float* nk, const float* nv, const float* nlf,
                                                 const bf16* Qs, bf16* AOs, const int tid) {
    const int lane = tid & 63, wid = __builtin_amdgcn_readfirstlane(tid >> 6), r32 = lane & 31, hi = lane >> 5;
    LAS float* bias = (LAS float*)(lds + BIAS_OFF); LAS float* wtot = (LAS float*)(lds + SCAN_OFF);
    {
        float v[5]; float run = 0.f;
#pragma unroll
        for (int i = 0; i < 5; ++i) { const int e = 5 * tid + i; float x = 0.f; if (e < 2048) x = clf[(size_t)e * 8]; else if (e < 2080) x = nlf[(size_t)(e - 2048) * 8]; run += x; v[i] = run; }
        const float sc = wave_incl_scan(run, lane);
        if (lane == 63) wtot[wid] = sc;
        __syncthreads();
        float off = sc - run;
#pragma unroll
        for (int w = 0; w < 8; ++w) if (w < wid) off += wtot[w];
#pragma unroll
        for (int i = 0; i < 5; ++i) { const int e = 5 * tid + i; if (e < 2080) bias[e] = -(off + v[i]) * LOG2E; }
        __syncthreads();
    }
    bf16x8 qr[4];
#pragma unroll
    for (int d0 = 0; d0 < 4; ++d0) qr[d0] = *(const bf16x8*)(Qs + (size_t)r32 * 512 + d0 * 16 + hi * 8);
    float m_run = -INFINITY, l_run = 0.f; f32x16 o0 = {}, o1 = {};
    for (int j = wid; j < 64; j += 8) samp_tile(ck + (size_t)j * 32 * 512, cv + (size_t)j * 32 * 512, bias + j * 32, false, qr, r32, hi, m_run, l_run, o0, o1);
    if (wid == 0) samp_tile(nk, nv, bias + 2048, true, qr, r32, hi, m_run, l_run, o0, o1);
    LAS float* po = (LAS float*)lds + wid * 2048; LAS float* pm = (LAS float*)lds + 16384;
#pragma unroll
    for (int r = 0; r < 16; ++r) { const int d = (r & 3) + 8 * (r >> 2) + 4 * hi; po[d * 32 + r32] = o0[r]; po[(32 + d) * 32 + r32] = o1[r]; }
    const float lt = half_sum(l_run);
    if (hi == 0) { pm[wid * 64 + r32] = m_run; pm[wid * 64 + 32 + r32] = lt; }
    __syncthreads();
    {
        const int q = tid & 31, d0 = (tid >> 5) * 4;
        float mw[8], M = -INFINITY;
#pragma unroll
        for (int w = 0; w < 8; ++w) { mw[w] = pm[w * 64 + q]; M = fmaxf(M, mw[w]); }
        float den = 0.f, num[4] = {0.f, 0.f, 0.f, 0.f};
#pragma unroll
        for (int w = 0; w < 8; ++w) { const float e = __builtin_amdgcn_exp2f(mw[w] - M); den += e * pm[w * 64 + 32 + q];
#pragma unroll
            for (int i = 0; i < 4; ++i) num[i] += e * ((LAS float*)lds)[w * 2048 + (d0 + i) * 32 + q]; }
        const float inv = 1.f / den;
        u32x2v o; o.x = cvtpk(num[0] * inv, num[1] * inv); o.y = cvtpk(num[2] * inv, num[3] * inv);
        *(u32x2v*)(AOs + (size_t)q * 1024 + d0) = o;
    }
    __syncthreads();
}
__device__ __forceinline__ void ln_pass(const int gw, const int NGW, const int lane, const float* xp0, const float* xs0, const float* Y, float* X, bf16* XN, const float* gp, const float* bp) {
    f32x4 gv[4], bv[4];
#pragma unroll
    for (int j = 0; j < 4; ++j) { gv[j] = ((const f32x4*)gp)[lane + 64 * j]; bv[j] = ((const f32x4*)bp)[lane + 64 * j]; }
    for (int m = gw; m < MT; m += NGW) {
        const float* base = xp0 ? (m < MP ? xp0 + (size_t)m * DM : xs0 + (size_t)(m - MP) * DM) : X + (size_t)m * DM;
        const GAS f32x4* br = (const GAS f32x4*)base + lane; const GAS f32x4* yr = (const GAS f32x4*)(Y + (size_t)m * DM) + lane;
        f32x4 v[4]; float s = 0.f;
#pragma unroll
        for (int j = 0; j < 4; ++j) { v[j] = br[64 * j] * ALPHA + yr[64 * j]; s += (v[j].x + v[j].y) + (v[j].z + v[j].w); }
        const float mean = wave_sum(s) * (1.f / DM); float s2 = 0.f;
#pragma unroll
        for (int j = 0; j < 4; ++j) { v[j] = v[j] - mean; s2 += (v[j].x * v[j].x + v[j].y * v[j].y) + (v[j].z * v[j].z + v[j].w * v[j].w); }
        const float rstd = 1.f / sqrtf(wave_sum(s2) * (1.f / DM) + LN_EPS);
        GAS f32x4* xo = (GAS f32x4*)(X + (size_t)m * DM) + lane; GAS u32x2v* o8 = (GAS u32x2v*)(XN + (size_t)m * DM) + lane;
#pragma unroll
        for (int j = 0; j < 4; ++j) { const f32x4 o = v[j] * rstd * gv[j] + bv[j]; xo[64 * j] = o; u32x2v w; w.x = cvtpk(o.x, o.y); w.y = cvtpk(o.z, o.w); o8[64 * j] = w; }
    }
}
__device__ __forceinline__ void unpack8(const v4u w, float (&f)[8]) { f[0] = bf_lo(w.x); f[1] = bf_hi(w.x); f[2] = bf_lo(w.y); f[3] = bf_hi(w.y); f[4] = bf_lo(w.z); f[5] = bf_hi(w.z); f[6] = bf_lo(w.w); f[7] = bf_hi(w.w); }
__device__ __forceinline__ void load8f(const float* p, float (&f)[8]) { const f32x4 a = *(const f32x4*)p, b = *(const f32x4*)(p + 4); f[0] = a.x; f[1] = a.y; f[2] = a.z; f[3] = a.w; f[4] = b.x; f[5] = b.y; f[6] = b.z; f[7] = b.w; }
__device__ __forceinline__ v4u pack8(const float (&f)[8]) { v4u o; o.x = cvtpk(f[0], f[1]); o.y = cvtpk(f[2], f[3]); o.z = cvtpk(f[4], f[5]); o.w = cvtpk(f[6], f[7]); return o; }
__device__ __forceinline__ void convmix_pass(const int gw, const int NGW, const int lane, const bf16* U, const bf16* Bg, bf16* AO, const float* cw, const float* cb, const float* state  ) {
    float w0[8], w1[8], w2[8], b0[8];
    load8f(cw + 8 * lane, w0); load8f(cw + 512 + 8 * lane, w1); load8f(cw + 1024 + 8 * lane, w2); load8f(cb + 8 * lane, b0);
    for (int ch = gw; ch < MT / 16; ch += NGW) {
        const int row0 = ch * 16; const bool samp = row0 >= MP; const int t0 = samp ? ((row0 - MP) & 31) : (row0 & 2047);
        float p2[8], p1[8];
        if (t0 == 0) {
            if (samp) { const float* st = state + (size_t)((row0 - MP) >> 5) * 2 * 512 + 8 * lane; load8f(st, p2); load8f(st + 512, p1); }
            else {
#pragma unroll
                for (int j = 0; j < 8; ++j) { p2[j] = 0.f; p1[j] = 0.f; } }
        } else { unpack8(*(const GAS v4u*)(U + (size_t)(row0 - 2) * 512 + 8 * lane), p2); unpack8(*(const GAS v4u*)(U + (size_t)(row0 - 1) * 512 + 8 * lane), p1); }
#pragma unroll 4
        for (int i = 0; i < 16; ++i) { const size_t row = (size_t)(row0 + i);
            float uc[8], bg[8], o[8]; unpack8(*(const GAS v4u*)(U + row * 512 + 8 * lane), uc); unpack8(*(const GAS v4u*)(Bg + row * 512 + 8 * lane), bg);
#pragma unroll
            for (int j = 0; j < 8; ++j) { o[j] = bg[j] * (b0[j] + w0[j] * p2[j] + w1[j] * p1[j] + w2[j] * uc[j]); p2[j] = p1[j]; p1[j] = uc[j]; }
            *(GAS v4u*)(AO + row * 1024 + 512 + 8 * lane) = pack8(o); }
    }
}
__device__ __forceinline__ void ffnconv_pass(const int gw, const int NGW, const int lane, const bf16* Gb, const bf16* Vb, bf16* A2, const float* cw, const float* cb, const float* state  ) {
    for (int it = gw; it < (MT / 16) * 6; it += NGW) {
        const int cg = it % 6, ch = it / 6, c = cg * 512 + 8 * lane;
        if (c < DFF) {
            float w0[8], w1[8], w2[8], b0[8];
            load8f(cw + c, w0); load8f(cw + DFF + c, w1); load8f(cw + 2 * DFF + c, w2); load8f(cb + c, b0);
            const int row0 = ch * 16; const bool samp = row0 >= MP; const int t0 = samp ? ((row0 - MP) & 31) : (row0 & 2047);
            float p2[8], p1[8];
            if (t0 == 0) {
                if (samp) { const float* st = state + (size_t)((row0 - MP) >> 5) * 2 * DFF + c; load8f(st, p2); load8f(st + DFF, p1); }
                else {
#pragma unroll
                    for (int j = 0; j < 8; ++j) { p2[j] = 0.f; p1[j] = 0.f; } }
            } else { unpack8(*(const GAS v4u*)(Gb + (size_t)(row0 - 2) * DFF + c), p2); unpack8(*(const GAS v4u*)(Gb + (size_t)(row0 - 1) * DFF + c), p1); }
#pragma unroll 4
            for (int i = 0; i < 16; ++i) { const size_t row = (size_t)(row0 + i);
                float gc[8], vv[8], o[8]; unpack8(*(const GAS v4u*)(Gb + row * DFF + c), gc); unpack8(*(const GAS v4u*)(Vb + row * DFF + c), vv);
#pragma unroll
                for (int j = 0; j < 8; ++j) { const float p = b0[j] + w0[j] * p2[j] + w1[j] * p1[j] + w2[j] * gc[j];
                    o[j] = p * __builtin_amdgcn_rcpf(1.f + __builtin_amdgcn_exp2f(-LOG2E * p)) * vv[j]; p2[j] = p1[j]; p1[j] = gc[j]; }
                *(GAS v4u*)(A2 + row * DFF + c) = pack8(o); }
        }
    }
}

struct Args { const float* in[20]; float* out; unsigned char* ws; };
typedef const __attribute__((address_space(4))) Args* KArgs;
__device__ __forceinline__ KArgs kargs() { KArgs p = (KArgs)__builtin_amdgcn_kernarg_segment_ptr(); asm volatile("" : "+s"(p)); return p; }
__global__ void __launch_bounds__(NWAVES * 64, 2) fox_fwd(Args args_unused) {
    extern __shared__ __attribute__((aligned(16))) unsigned char lds[];
    LAS unsigned char* L = (LAS unsigned char*)lds;
#define TIDL() ({ int t_ = threadIdx.x; asm volatile("" : "+v"(t_)); t_; })
    int tid = TIDL();
#define LANE (tid & 63)
#define WAVE __builtin_amdgcn_readfirstlane(tid >> 6)
#define GG ({ int g_ = (int)gridDim.x; asm volatile("" : "+s"(g_)); g_; })
#define BX ({ int b_ = (int)blockIdx.x; asm volatile("" : "+s"(b_)); b_; })
#define VCU ((GG % 8 == 0) ? (BX % 8) * (GG / 8) + BX / 8 : BX)
#define GW (VCU * NWAVES + WAVE)
#define NGW_ (GG * NWAVES)
    for (int u = tid; u < (LDS_BYTES - LDSCTL_OFF) / 4; u += NWAVES * 64) ((LAS unsigned*)(L + LDSCTL_OFF))[u] = 0u;
    __syncthreads();
    XcdBarrier bar = xcd_barrier_post((unsigned*)(kargs()->ws + WS_CTL) + CW_BAR, (volatile LAS unsigned*)(L + MISC_OFF) + 8);
#define GRID_BAR() do { XcdBarrier b_ = bar; asm volatile("" : "+s"(b_.bar), "+s"(b_.x)); xcd_barrier(b_); } while (0)

    {
        const KArgs ka = kargs(); unsigned char* ws = ka->ws; tid = TIDL(); const int lane = LANE, gw = GW, NGW = NGW_;
        LAS float* scr = (LAS float*)(L + RING_OFF + WAVE * 16384);
        constexpr int I_IN = 16 * (NIN / 32), I_OUT = 16 * 32, I_UP = 16 * (NUP / 32), I_DN = (DFF / 64) * 32, I_L = I_IN + I_OUT + I_UP + I_DN;
        for (int it = gw; it < DEPTH * I_L; it += NGW) {
            const int l = it / I_L; int r = it % I_L;
            bf16* wl = (bf16*)(ws + WS_W + (size_t)l * W_LAYER_B);
            if (r < I_IN) { const int nb = r % (NIN / 32), kb = r / (NIN / 32), n0 = 32 * nb; int src = 0, nv = 32;
                if (n0 < 1536) src = n0; else if (n0 < 2048) src = 1544 + (n0 - 1536);
                else if (n0 < 3072) { const int j = (n0 - 2048) >> 8, rr = (n0 - 2048) & 255; src = rr < 128 ? 2056 + 128 * j + rr : 2568 + 128 * j + (rr - 128); }
                else if (n0 == 3072) { src = 1536; nv = 8; } else nv = 0;
                transpose_item(ka->in[7] + (size_t)l * DM * DIN, DIN, src, nv, 64 * kb, wl, DM, n0, scr, lane); continue; }
            r -= I_IN;
            if (r < I_OUT) { const int nb = r % 32, kb = r / 32; transpose_item(ka->in[11] + (size_t)l * DM * DM, DM, 32 * nb, 32, 64 * kb, wl + (size_t)NIN * DM, DM, 32 * nb, scr, lane); continue; }
            r -= I_OUT;
            if (r < I_UP) { const int nb = r % (NUP / 32), kb = r / (NUP / 32); transpose_item(ka->in[14] + (size_t)l * DM * NUP, NUP, 32 * nb, 32, 64 * kb, wl + (size_t)(NIN + DM) * DM, DM, 32 * nb, scr, lane); continue; }
            r -= I_UP;
            { const int nb = r % 32, kb = r / 32; transpose_item(ka->in[17] + (size_t)l * DFF * DM, DM, 32 * nb, 32, 64 * kb, wl + (size_t)(NIN + DM + NUP) * DM, DFF, 32 * nb, scr, lane); }
        }
        bf16* XN = (bf16*)(ws + WS_XN); const float* xp = ka->in[0]; const float* xs = ka->in[1];
        for (int m = gw; m < MT; m += NGW) {
            const float* xr = m < MP ? xp + (size_t)m * DM : xs + (size_t)(m - MP) * DM;
            const GAS f32x4* x4 = (const GAS f32x4*)xr + lane; GAS u32x2v* o8 = (GAS u32x2v*)(XN + (size_t)m * DM) + lane;
#pragma unroll
            for (int j = 0; j < 4; ++j) { const f32x4 v = x4[64 * j]; u32x2v w; w.x = cvtpk(v.x, v.y); w.y = cvtpk(v.z, v.w); o8[64 * j] = w; }
        }
    }
    GRID_BAR();

    for (int l = 0; l < DEPTH; ++l) {
        {
            const KArgs ka = kargs(); unsigned char* ws = ka->ws; tid = TIDL();
            pg8::Gemm g{(const bf16*)(ws + WS_XN), (const bf16*)(ws + WS_W + (size_t)l * W_LAYER_B), MT, NIN, DM}; pg8::StaticOrder S; S.init(MT, NIN, GG, BX);
            pg8::EpiInProj E{ws, ka->out, ka->in[8] + l * NH, l, QSCALE};
            pg8::gemm_phase<pg8::EpiInProj, pg8::StaticOrder, true, true>(L + RING_OFF, g, S, E);
        }
        GRID_BAR();
#ifndef NO_CONVMIX
        {
            const KArgs ka = kargs(); unsigned char* ws = ka->ws; tid = TIDL();
            convmix_pass(GW, NGW_, LANE, (const bf16*)(ws + WS_U), (const bf16*)(ws + WS_BG), (bf16*)(ws + WS_AO), ka->in[9] + (size_t)l * 3 * DCONV, ka->in[10] + (size_t)l * DCONV, ka->in[5] + (size_t)l * NB * 2 * DCONV);
        }
#endif
#ifndef NO_PATTN
        for (int bh = VCU; bh < NB * NH; bh += GG) {
            const int b = bh >> 3, h = bh & 7; tid = TIDL();
            LAS float* bias = (LAS float*)(L + BIAS_OFF); LAS float* wtot = (LAS float*)(L + SCAN_OFF);
            {
                const int lane = LANE, wave = WAVE;
                const float* lf = kargs()->out + OUT_LFP + ((size_t)l * MP + (size_t)b * SEQ) * NH + h;
                float v[4]; float run = 0.f;
#pragma unroll
                for (int i = 0; i < 4; ++i) { run += lf[(size_t)(4 * tid + i) * NH]; v[i] = run; }
                const float sc = wave_incl_scan(run, lane);
                if (lane == 63) wtot[wave] = sc;
                __syncthreads();
                float off = sc - run;
#pragma unroll
                for (int w = 0; w < 8; ++w) if (w < wave) off += wtot[w];
#pragma unroll
                for (int i = 0; i < 4; ++i) bias[4 * tid + i] = -(off + v[i]) * LOG2E;
                __syncthreads();
            }
            for (int i = 0; i < 8; ++i) { const int qb = (i & 1) ? (i >> 1) : 7 - (i >> 1);
                unsigned char* ws = kargs()->ws;
                attn_body::attn_unit<60>(b, h, qb, (const attn_body::bf16*)(ws + WS_Q), (const attn_body::bf16*)(ws + WS_K), (const attn_body::bf16*)(ws + WS_V), (attn_body::bf16*)(ws + WS_AO), (char*)lds + RING_OFF, (attn_body::lds_cfptr)bias); }
            __syncthreads();
        }
#endif
#ifndef NO_SATTN
        for (int bh = VCU; bh < NB * NH; bh += GG) {
            const KArgs ka = kargs(); unsigned char* ws = ka->ws; tid = TIDL(); float* out = ka->out;
            const int b = bh >> 3, h = bh & 7; const size_t lb = (size_t)l * NB + b;
            sample_attn_unit(L, ka->in[2] + lb * PAST * DATT + h * HD, ka->in[3] + lb * PAST * DATT + h * HD, ka->in[4] + lb * PAST * NH + h,
                             out + OUT_KS + ((size_t)l * MS + b * DSEQ) * DATT + h * HD, out + OUT_VS + ((size_t)l * MS + b * DSEQ) * DATT + h * HD, out + OUT_LFS + ((size_t)l * MS + b * DSEQ) * NH + h,
                             (const bf16*)(ws + WS_Q) + (size_t)(MP + b * DSEQ) * DATT + h * HD, (bf16*)(ws + WS_AO) + (size_t)(MP + b * DSEQ) * DM + h * HD, tid);
        }
#endif
        GRID_BAR();
        {
            const KArgs ka = kargs(); unsigned char* ws = ka->ws; tid = TIDL();
            pg8::Gemm g{(const bf16*)(ws + WS_AO), (const bf16*)(ws + WS_W + (size_t)l * W_LAYER_B) + (size_t)NIN * DM, MT, DM, DM}; pg8::StaticOrder S; S.init(MT, DM, GG, BX);
            pg8::EpiF32 E{(float*)(ws + WS_Y), DM};
            pg8::gemm_phase<pg8::EpiF32, pg8::StaticOrder, true, true>(L + RING_OFF, g, S, E);
        }
        GRID_BAR();
        {
            const KArgs ka = kargs(); unsigned char* ws = ka->ws; tid = TIDL();
            ln_pass(GW, NGW_, LANE, l == 0 ? ka->in[0] : nullptr, ka->in[1], (const float*)(ws + WS_Y), ka->out + OUT_Y, (bf16*)(ws + WS_XN), ka->in[12] + (size_t)l * DM, ka->in[13] + (size_t)l * DM);
        }
        GRID_BAR();
        {
            const KArgs ka = kargs(); unsigned char* ws = ka->ws; tid = TIDL();
            pg8::Gemm g{(const bf16*)(ws + WS_XN), (const bf16*)(ws + WS_W + (size_t)l * W_LAYER_B) + (size_t)(NIN + DM) * DM, MT, NUP, DM}; pg8::StaticOrder S; S.init(MT, NUP, GG, BX);
            pg8::EpiUp E{ws, ka->out, l};
            pg8::gemm_phase<pg8::EpiUp, pg8::StaticOrder, true, true>(L + RING_OFF, g, S, E);
        }
        GRID_BAR();
        {
            const KArgs ka = kargs(); unsigned char* ws = ka->ws; tid = TIDL();
            ffnconv_pass(GW, NGW_, LANE, (const bf16*)(ws + WS_G), (const bf16*)(ws + WS_VAL), (bf16*)(ws + WS_A2), ka->in[15] + (size_t)l * 3 * DFF, ka->in[16] + (size_t)l * DFF, ka->in[6] + (size_t)l * NB * 2 * DFF);
        }
        GRID_BAR();
        {
            const KArgs ka = kargs(); unsigned char* ws = ka->ws; tid = TIDL();
            pg8::Gemm g{(const bf16*)(ws + WS_A2), (const bf16*)(ws + WS_W + (size_t)l * W_LAYER_B) + (size_t)(NIN + DM + NUP) * DM, MT, DM, DFF}; pg8::StaticOrder S; S.init(MT, DM, GG, BX);
            pg8::EpiF32 E{(float*)(ws + WS_Y), DM};
            pg8::gemm_phase<pg8::EpiF32, pg8::StaticOrder, true, true>(L + RING_OFF, g, S, E);
        }
        GRID_BAR();
        {
            const KArgs ka = kargs(); unsigned char* ws = ka->ws; tid = TIDL();
            ln_pass(GW, NGW_, LANE, nullptr, nullptr, (const float*)(ws + WS_Y), ka->out + OUT_Y, (bf16*)(ws + WS_XN), ka->in[18] + (size_t)l * DM, ka->in[19] + (size_t)l * DM);
        }
        if (l + 1 < DEPTH) GRID_BAR();
    }
#undef GRID_BAR
}

extern "C" void kernel_launch(void* const* d_in, const int* in_sizes, int n_in, void* d_out, int out_size, void* d_ws, size_t ws_size, hipStream_t stream) {
    static int grid = 0;
    if (grid == 0) {
        if (n_in != 20 || (size_t)out_size != OUT_END || ws_size < WS_END) { fprintf(stderr, "kernel_launch: built for 20 inputs, %zu outputs, >= %zu bytes of workspace; got n_in %d, out %d, ws %zu; nothing launched\n", (size_t)OUT_END, (size_t)WS_END, n_in, out_size, ws_size); grid = -1; return; }
        int dev = 0, cus = 0, per_cu = 0;
        if (hipGetDevice(&dev) != hipSuccess || hipDeviceGetAttribute(&cus, hipDeviceAttributeMultiprocessorCount, dev) != hipSuccess) { fprintf(stderr, "kernel_launch: device query failed\n"); grid = -1; return; }
        if (hipFuncSetAttribute((const void*)fox_fwd, hipFuncAttributeMaxDynamicSharedMemorySize, LDS_BYTES) != hipSuccess) { fprintf(stderr, "kernel_launch: hipFuncSetAttribute failed\n"); grid = -1; return; }
        if (hipOccupancyMaxActiveBlocksPerMultiprocessor(&per_cu, (const void*)fox_fwd, NWAVES * 64, LDS_BYTES) != hipSuccess || per_cu < 1) { fprintf(stderr, "kernel_launch: occupancy query reports %d workgroups per CU\n", per_cu); }
        (void)hipGetLastError();
        grid = cus;
    }
    if (grid < 0) return;
    if (hipMemsetAsync((char*)d_ws + WS_CTL, 0, CTL_ZERO_BYTES, stream) != hipSuccess) { fprintf(stderr, "kernel_launch: hipMemsetAsync failed\n"); return; }
    Args a{};
    for (int i = 0; i < 20; ++i) a.in[i] = (const float*)d_in[i];
    a.out = (float*)d_out; a.ws = (unsigned char*)d_ws;
    hipLaunchKernelGGL(fox_fwd, dim3(grid), dim3(NWAVES * 64), LDS_BYTES, stream, a);
    const hipError_t le = hipPeekAtLastError();
    if (le != hipSuccess) fprintf(stderr, "kernel_launch: launch failed: %s\n", hipGetErrorName(le));
}
```
